# Optimizing an MI355X kernel written in HIP

```python
import math
import jax, jax.numpy as jnp
from jax import lax
import numpy as np

D_MODEL = 2048
BATCH = 8
SEQ = 2048
DEPTH = 2

MEM_LEN = 256
CHUNK = 128
Q_BLOCK = 128
D_A = D_MODEL // 2
A_GROUPS = 8
A_GROUP_DIM = D_A // A_GROUPS
D_B = D_MODEL // 4
B_HEADS = 4
B_HEAD_DIM = D_B // B_HEADS
D_C = D_MODEL // 4
C_HEADS = 4
C_HEAD_DIM = D_C // C_HEADS
SPLIT_SIZES = (D_A, D_A, D_A, D_B, D_B, D_B, D_B, D_C, D_C)
IN_WIDTH = sum(SPLIT_SIZES)
EPS = 1e-6

kernel_name = "hybrid_sgu_stickbreak_memxattn"


def rms_norm(x, g):
    xf = x.astype(jnp.float32)
    y = xf * lax.rsqrt(jnp.mean(xf * xf, axis=-1, keepdims=True) + EPS)
    return (y * g.astype(jnp.float32)).astype(x.dtype)


def layer_norm(x, g, b):
    xf = x.astype(jnp.float32)
    mu = jnp.mean(xf, axis=-1, keepdims=True)
    xc = xf - mu
    y = xc * lax.rsqrt(jnp.mean(xc * xc, axis=-1, keepdims=True) + EPS)
    return (y * g.astype(jnp.float32) + b.astype(jnp.float32)).astype(x.dtype)


def sgu_mixer(u, v, ln_g, ln_b, w_s, b_s):
    bsz, s_len, _ = v.shape
    n_chunks = s_len // CHUNK
    v = layer_norm(v, ln_g, ln_b)
    vc = v.reshape(bsz, n_chunks, CHUNK, A_GROUPS, A_GROUP_DIM)
    mask = jnp.tril(jnp.ones((CHUNK, CHUNK), dtype=bool))
    w = jnp.where(mask[None], w_s, jnp.zeros_like(w_s))
    mixed = jnp.einsum('gts,bcsgd->bctgd', w, vc) + b_s.T[None, None, :, :, None]
    return u * mixed.reshape(bsz, s_len, D_A)


def stick_breaking_attention(q, k, v):
    s_len = q.shape[1]
    scale = 1.0 / math.sqrt(q.shape[-1])
    outs = []
    for i in range(s_len // Q_BLOCK):
        start = i * Q_BLOCK
        kv_len = start + Q_BLOCK
        q_blk = q[:, start:kv_len]
        k_blk = k[:, :kv_len]
        v_blk = v[:, :kv_len]
        z = jnp.einsum('bthd,bshd->bhts', q_blk, k_blk).astype(jnp.float32) * scale
        t_idx = start + jnp.arange(Q_BLOCK)[:, None]
        s_idx = jnp.arange(kv_len)[None, :]
        causal = s_idx < t_idx
        log_beta = jax.nn.log_sigmoid(z)
        log_1mb = jnp.where(causal, jax.nn.log_sigmoid(-z), 0.0)
        rc = lax.cumsum(log_1mb, axis=3, reverse=True)
        after = jnp.pad(rc[..., 1:], ((0, 0), (0, 0), (0, 0), (0, 1)))
        a = jnp.where(causal, jnp.exp(log_beta + after), 0.0)
        outs.append(jnp.einsum('bhts,bshd->bthd', a.astype(v.dtype), v_blk))
    return jnp.concatenate(outs, axis=1)


def memory_attention(q, mem_k, mem_v, q_g, k_g):
    scale = 1.0 / math.sqrt(q.shape[-1])
    qn = rms_norm(q, q_g)
    kn = rms_norm(mem_k, k_g)
    s = jnp.einsum('bthd,bmhd->bhtm', qn, kn).astype(jnp.float32) * scale
    p = jax.nn.softmax(s, axis=-1)
    return jnp.einsum('bhtm,bmhd->bthd', p.astype(mem_v.dtype), mem_v)


def setup_inputs(seed: int = 0) -> dict:
    key = jax.random.key(seed)
    ks = jax.random.split(key, 16)
    f32 = jnp.float32
    x = jax.random.normal(ks[0], (BATCH, SEQ, D_MODEL), f32)
    mem = jax.random.normal(ks[1], (BATCH, MEM_LEN, D_MODEL), f32)
    norm_g = 1.0 + 0.01 * jax.random.normal(ks[2], (DEPTH, D_MODEL), f32)
    w_in = jax.random.normal(ks[3], (DEPTH, D_MODEL, IN_WIDTH), f32) * D_MODEL ** -0.5
    sgu_ln_g = 1.0 + 0.01 * jax.random.normal(ks[4], (DEPTH, D_A), f32)
    sgu_ln_b = 0.01 * jax.random.normal(ks[5], (DEPTH, D_A), f32)
    sgu_w = jax.random.normal(ks[6], (DEPTH, A_GROUPS, CHUNK, CHUNK), f32) * CHUNK ** -0.5
    sgu_b = 1.0 + 0.01 * jax.random.normal(ks[7], (DEPTH, A_GROUPS, CHUNK), f32)
    mem_norm_g = 1.0 + 0.01 * jax.random.normal(ks[8], (DEPTH, D_MODEL), f32)
    w_mem_kv = jax.random.normal(ks[9], (DEPTH, D_MODEL, 2 * D_C), f32) * D_MODEL ** -0.5
    q_norm_g = 1.0 + 0.01 * jax.random.normal(ks[10], (DEPTH, C_HEAD_DIM), f32)
    k_norm_g = 1.0 + 0.01 * jax.random.normal(ks[11], (DEPTH, C_HEAD_DIM), f32)
    w_out = jax.random.normal(ks[12], (DEPTH, D_MODEL, D_MODEL), f32) * D_MODEL ** -0.5
    return {"x": x, "mem": mem, "norm_g": norm_g, "w_in": w_in,
            "sgu_ln_g": sgu_ln_g, "sgu_ln_b": sgu_ln_b, "sgu_w": sgu_w, "sgu_b": sgu_b,
            "mem_norm_g": mem_norm_g, "w_mem_kv": w_mem_kv,
            "q_norm_g": q_norm_g, "k_norm_g": k_norm_g, "w_out": w_out}


def reference(x, mem, norm_g, w_in, sgu_ln_g, sgu_ln_b, sgu_w, sgu_b,
              mem_norm_g, w_mem_kv, q_norm_g, k_norm_g, w_out):
    bsz, s_len, _ = x.shape
    split_idx = list(np.cumsum(SPLIT_SIZES)[:-1])
    for l in range(DEPTH):
        h = rms_norm(x, norm_g[l])
        proj = jnp.matmul(h, w_in[l])
        u_a, v_a, z_a, q_b, k_b, v_b, z_b, q_c, z_c = jnp.split(proj, split_idx, axis=-1)

        u_a = jax.nn.gelu(u_a, approximate=False)
        v_a = jax.nn.gelu(v_a, approximate=False)
        y_a = sgu_mixer(u_a, v_a, sgu_ln_g[l], sgu_ln_b[l], sgu_w[l], sgu_b[l]) * jax.nn.silu(z_a)

        hb = (bsz, s_len, B_HEADS, B_HEAD_DIM)
        y_b = stick_breaking_attention(q_b.reshape(hb), k_b.reshape(hb), v_b.reshape(hb))
        y_b = y_b.reshape(bsz, s_len, D_B) * jax.nn.silu(z_b)

        mem_h = rms_norm(mem, mem_norm_g[l])
        mem_kv = jnp.matmul(mem_h, w_mem_kv[l])
        mem_k, mem_v = jnp.split(mem_kv, 2, axis=-1)
        hm = (bsz, mem.shape[1], C_HEADS, C_HEAD_DIM)
        y_c = memory_attention(q_c.reshape(bsz, s_len, C_HEADS, C_HEAD_DIM),
                               mem_k.reshape(hm), mem_v.reshape(hm), q_norm_g[l], k_norm_g[l])
        y_c = y_c.reshape(bsz, s_len, D_C) * jax.nn.silu(z_c)

        y = jnp.concatenate([y_a, y_b, y_c], axis=-1)
        x = x + jnp.matmul(y, w_out[l])
    return x
```

```cpp
#include <hip/hip_runtime.h>
#include <hip/hip_cooperative_groups.h>
#include <cstdio>
#include <cstdint>
namespace cg = cooperative_groups;
namespace pg8 {
#define PG8_LAS __attribute__((address_space(3)))
typedef unsigned short bf16_t;
typedef short bf16x8 __attribute__((ext_vector_type(8)));
typedef float f32x4 __attribute__((ext_vector_type(4)));
typedef unsigned u32x4 __attribute__((ext_vector_type(4)));
constexpr int BM = 256, BK = 64, HALF = 128, HTB = HALF * BK * 2  , STAGE_BYTES = 8 * HTB, NXCD = 8, WGM = 4;

__host__ __device__ __forceinline__ int lds_byte(int r, int c) { const int st = (r >> 4) * 2 + (c >> 5), rr = r & 15, cc = c & 31, ob = rr * 64 + cc * 2; return st * 1024 + (ob ^ (((ob >> 9) & 1) << 5)); }
__host__ __device__ __forceinline__ void stage_rc(int b, int& R, int& C) { const int st = b / 1024, sb = b % 1024, swz = sb ^ (((sb >> 9) & 1) << 5); R = (st >> 1) * 16 + swz / 64; C = (st & 1) * 32 + (swz % 64) / 2; }
__host__ __device__ __forceinline__ int perm32(int rho) { const int n = rho >> 4, i = rho & 15; return 8 * (i >> 2) + 4 * n + (i & 3); }

struct Unit { int pm, pn; };
struct Gemm { const bf16_t* A; const bf16_t* Bt; int M, N, K; };

struct StaticOrder {
    int nM, nN, nwg, G, c;
    __host__ __device__ void init(int M, int N, int G_, int c_) { nM = M / BM; nN = N / BM; nwg = nM * nN; G = G_; c = c_; }
    __host__ __device__ bool next(int i, Unit& u) const {
        const long L = (long)i * G + c; if (L >= nwg) return false;
        int wgid = (int)L; { const int q = nwg / NXCD, r = nwg % NXCD, xcd = wgid % NXCD, off = wgid / NXCD; wgid = (xcd < r ? xcd * (q + 1) : r * (q + 1) + (xcd - r) * q) + off; }
        const int nig = WGM * nN, gid = wgid / nig, fm = gid * WGM, gsz = (nM - fm) < WGM ? (nM - fm) : WGM;
        u.pm = fm + ((wgid % nig) % gsz); u.pn = (wgid % nig) / gsz; return true;
    }
    __device__ __forceinline__ void a_ready(const Unit&) const {}
    __device__ __forceinline__ void done(const Unit&) const {}
};

__device__ __forceinline__ unsigned cvt_pk_bf16(float lo, float hi) { unsigned r; asm volatile("v_cvt_pk_bf16_f32 %0, %1, %2" : "=v"(r) : "v"(lo), "v"(hi)); return r; }
typedef float f32x2 __attribute__((ext_vector_type(2)));
__device__ __forceinline__ f32x2 gelu_pk(f32x2 v) {
    const f32x2 av = __builtin_elementwise_abs(v), d = av * 0.2316418882f + 1.0f;
    f32x2 t; t.x = __builtin_amdgcn_rcpf(d.x); t.y = __builtin_amdgcn_rcpf(d.y);
    f32x2 q = t * 0.5307027145f + (-0.7265760135f); q = q * t + 0.7107068705f; q = q * t + (-0.142248368f); q = q * t + 0.127414796f; q = q * t;
    const f32x2 s = (v * v) * (-0.72134752044f);
    f32x2 e; e.x = __builtin_amdgcn_exp2f(s.x); e.y = __builtin_amdgcn_exp2f(s.y);
    const f32x2 m = v * (q * e), r = v - m;
    f32x2 o; o.x = v.x < 0.f ? m.x : r.x; o.y = v.y < 0.f ? m.y : r.y; return o;
}

__device__ __forceinline__ float silu_f(float v) { return v * __builtin_amdgcn_rcpf(1.0f + __builtin_amdgcn_exp2f(-1.4426950408889634f * v)); }
struct EpiIn {
    static constexpr bool PERM = true, AFTER_DRAIN = false;
    bf16_t* O; int ldc; const float* rowss; float* lnst; float inv_k; float eps;
    template <int MODE> __device__ __forceinline__ void body(const f32x4 (&acc)[2][2][4][2], const Unit& u, int wr, int wc, int fr, int fq) const {
        const int row0 = u.pm * BM + wr * 64 + fr; const int col0 = u.pn * BM + wc * 32 + 8 * fq;
#pragma unroll
        for (int ai = 0; ai < 2; ++ai)
#pragma unroll
            for (int m = 0; m < 4; ++m) {
                const int row = row0 + ai * HALF + m * 16;
                const float rs = __builtin_amdgcn_rsqf(rowss[row] * inv_k + eps);
                bf16_t* rowp = O + (size_t)row * ldc + col0; float s1 = 0.f, s2 = 0.f;
#pragma unroll
                for (int bj = 0; bj < 2; ++bj) { f32x4 v0 = acc[ai][bj][m][0] * rs, v1 = acc[ai][bj][m][1] * rs;
                    if (MODE == 0 || MODE == 1) { f32x2 a = gelu_pk((f32x2){v0[0], v0[1]}), b = gelu_pk((f32x2){v0[2], v0[3]}), c = gelu_pk((f32x2){v1[0], v1[1]}), d = gelu_pk((f32x2){v1[2], v1[3]});
                        v0 = (f32x4){a.x, a.y, b.x, b.y}; v1 = (f32x4){c.x, c.y, d.x, d.y}; }
                    if (MODE == 1) { s1 += ((v0[0] + v0[1]) + (v0[2] + v0[3])) + ((v1[0] + v1[1]) + (v1[2] + v1[3]));
                        s2 += ((v0[0] * v0[0] + v0[1] * v0[1]) + (v0[2] * v0[2] + v0[3] * v0[3])) + ((v1[0] * v1[0] + v1[1] * v1[1]) + (v1[2] * v1[2] + v1[3] * v1[3])); }
                    if (MODE == 2) { v0 = (f32x4){silu_f(v0[0]), silu_f(v0[1]), silu_f(v0[2]), silu_f(v0[3])}; v1 = (f32x4){silu_f(v1[0]), silu_f(v1[1]), silu_f(v1[2]), silu_f(v1[3])}; }
                    if (MODE == 3) { v0 = v0 * 0.12751743074602336f; v1 = v1 * 0.12751743074602336f; }
                    u32x4 w; w.x = cvt_pk_bf16(v0[0], v0[1]); w.y = cvt_pk_bf16(v0[2], v0[3]); w.z = cvt_pk_bf16(v1[0], v1[1]); w.w = cvt_pk_bf16(v1[2], v1[3]);
                    *(u32x4*)(rowp + bj * HALF) = w; }
                if (MODE == 1) { s1 += __shfl_xor(s1, 16); s1 += __shfl_xor(s1, 32); s2 += __shfl_xor(s2, 16); s2 += __shfl_xor(s2, 32);
                    if (fq == 0) { unsafeAtomicAdd(lnst + 2 * (size_t)row, s1); unsafeAtomicAdd(lnst + 2 * (size_t)row + 1, s2); } }
            }
    }
    __device__ __forceinline__ void operator()(const f32x4 (&acc)[2][2][4][2], const Unit& u, int wr, int wc, int fr, int fq) const {
        const int pn = u.pn;
        if (pn < 4) body<0>(acc, u, wr, wc, fr, fq);
        else if (pn < 8) body<1>(acc, u, wr, wc, fr, fq);
        else if (pn < 12 || pn == 18 || pn == 19 || pn >= 22) body<2>(acc, u, wr, wc, fr, fq);
        else if (pn < 14) body<3>(acc, u, wr, wc, fr, fq);
        else body<4>(acc, u, wr, wc, fr, fq);
    }
};
struct EpiKV {
    static constexpr bool PERM = true, AFTER_DRAIN = false;
    bf16_t* O; int ldc; const float* rs_;
    __device__ __forceinline__ void operator()(const f32x4 (&acc)[2][2][4][2], const Unit& u, int wr, int wc, int fr, int fq) const {
        const int row0 = u.pm * BM + wr * 64 + fr; const int col0 = u.pn * BM + wc * 32 + 8 * fq;
#pragma unroll
        for (int ai = 0; ai < 2; ++ai)
#pragma unroll
            for (int m = 0; m < 4; ++m) {
                const int row = row0 + ai * HALF + m * 16; const float rs = rs_[row];
                bf16_t* rowp = O + (size_t)row * ldc + col0;
#pragma unroll
                for (int bj = 0; bj < 2; ++bj) { f32x4 v0 = acc[ai][bj][m][0] * rs, v1 = acc[ai][bj][m][1] * rs;
                    u32x4 w; w.x = cvt_pk_bf16(v0[0], v0[1]); w.y = cvt_pk_bf16(v0[2], v0[3]); w.z = cvt_pk_bf16(v1[0], v1[1]); w.w = cvt_pk_bf16(v1[2], v1[3]);
                    *(u32x4*)(rowp + bj * HALF) = w; }
            }
    }
};
struct EpiOut {
    static constexpr bool PERM = true, AFTER_DRAIN = false;
    const float* basef; const bf16_t* baseb; float* out; int ldc; bf16_t* xb; float* rowss_next;
    __device__ __forceinline__ void operator()(const f32x4 (&acc)[2][2][4][2], const Unit& u, int wr, int wc, int fr, int fq) const {
        const int row0 = u.pm * BM + wr * 64 + fr; const int col0 = u.pn * BM + wc * 32 + 8 * fq;
#pragma unroll
        for (int ai = 0; ai < 2; ++ai)
#pragma unroll
            for (int m = 0; m < 4; ++m) {
                const int row = row0 + ai * HALF + m * 16; const size_t off = (size_t)row * ldc + col0; float ss = 0.f;
#pragma unroll
                for (int bj = 0; bj < 2; ++bj) {
                    f32x4 b0, b1;
                    if (basef) { b0 = *(const f32x4*)(basef + off + bj * HALF); b1 = *(const f32x4*)(basef + off + bj * HALF + 4); }
                    else { const u32x4 w = *(const u32x4*)(baseb + off + bj * HALF);
                        b0 = (f32x4){__uint_as_float(w.x << 16), __uint_as_float(w.x & 0xffff0000u), __uint_as_float(w.y << 16), __uint_as_float(w.y & 0xffff0000u)};
                        b1 = (f32x4){__uint_as_float(w.z << 16), __uint_as_float(w.z & 0xffff0000u), __uint_as_float(w.w << 16), __uint_as_float(w.w & 0xffff0000u)}; }
                    const f32x4 o0 = b0 + acc[ai][bj][m][0], o1 = b1 + acc[ai][bj][m][1];
                    if (out) { *(f32x4*)(out + off + bj * HALF) = o0; *(f32x4*)(out + off + bj * HALF + 4) = o1; }
                    if (xb) { u32x4 w; w.x = cvt_pk_bf16(o0[0], o0[1]); w.y = cvt_pk_bf16(o0[2], o0[3]); w.z = cvt_pk_bf16(o1[0], o1[1]); w.w = cvt_pk_bf16(o1[2], o1[3]);
                        *(u32x4*)(xb + off + bj * HALF) = w;
                        ss += ((o0[0] * o0[0] + o0[1] * o0[1]) + (o0[2] * o0[2] + o0[3] * o0[3])) + ((o1[0] * o1[0] + o1[1] * o1[1]) + (o1[2] * o1[2] + o1[3] * o1[3])); }
                }
                if (xb) { ss += __shfl_xor(ss, 16); ss += __shfl_xor(ss, 32); if (fq == 0) unsafeAtomicAdd(rowss_next + row, ss); }
            }
    }
};

template <class Epi, class Sched, bool ALIGN_EPI = false, bool SP2 = false>
__device__ __forceinline__ void gemm_phase(PG8_LAS unsigned char* lds, const Gemm g, const Sched& S, const Epi& E, int wave_in) {
    int tid_ = wave_in * 64 + (int)__builtin_amdgcn_mbcnt_hi(~0u, __builtin_amdgcn_mbcnt_lo(~0u, 0u)); asm volatile("" : "+v"(tid_));
    const int tid = tid_, wid = __builtin_amdgcn_readfirstlane(tid >> 6), lane = tid & 63, wr = wid >> 2, wc = wid & 3, fr = lane & 15, fq = lane >> 4;
    const int K = g.K, nt = K / BK;
    unsigned voffA[2], voffB[2];
#pragma unroll
    for (int i = 0; i < 2; ++i) { int R, C; stage_rc(tid * 16 + i * 8192, R, C); const int Rb = Epi::PERM ? ((R & ~31) + perm32(R & 31)) : R;
        voffA[i] = (unsigned)(R * K + C) * 2u; voffB[i] = (unsigned)(Rb * K + C) * 2u; }
    const size_t kstep = (size_t)(BK * 2);
    const size_t hstep = (size_t)HALF * K * 2;
    const size_t tstep = 2 * hstep;
    const unsigned ldsw = (unsigned)wid * 1024u;
    const int aoff = lds_byte(wr * 64 + fr, fq * 8), boff = lds_byte(wc * 32 + fr, fq * 8);
#define PG8_SA(b, h) (((b) * 2 + (h)) * HTB)
#define PG8_SB(b, h) ((4 + (b) * 2 + (h)) * HTB)
#define PG8_STAGE(bufoff, gbase, voff) do { _Pragma("unroll") for (int _i = 0; _i < 2; ++_i) \
        __builtin_amdgcn_global_load_lds((const unsigned*)((const char*)(gbase) + (voff)[_i]), (PG8_LAS unsigned*)(lds + (bufoff) + ldsw + _i * 8192), 16, 0, 0); } while (0)
#define PG8_LDA(dst, b, h) do { _Pragma("unroll") for (int m = 0; m < 4; ++m) _Pragma("unroll") for (int k = 0; k < 2; ++k) dst[m][k] = *(const PG8_LAS bf16x8*)(lds + PG8_SA(b, h) + aoff + m * 2048 + k * 1024); } while (0)
#define PG8_LDB(dst, b, h) do { _Pragma("unroll") for (int n = 0; n < 2; ++n) _Pragma("unroll") for (int k = 0; k < 2; ++k) dst[n][k] = *(const PG8_LAS bf16x8*)(lds + PG8_SB(b, h) + boff + n * 2048 + k * 1024); } while (0)
#define PG8_MMA(ai, bj, At, Bt) do { __builtin_amdgcn_s_setprio(1); _Pragma("unroll") for (int m = 0; m < 4; ++m) _Pragma("unroll") for (int n = 0; n < 2; ++n) _Pragma("unroll") for (int k = 0; k < 2; ++k) \
        acc[ai][bj][m][n] = __builtin_amdgcn_mfma_f32_16x16x32_bf16(Bt[n][k], At[m][k], acc[ai][bj][m][n], 0, 0, 0); __builtin_amdgcn_s_setprio(0); } while (0)
#define PG8_WAIT_V(n) asm volatile("s_waitcnt vmcnt(" #n ")" ::: "memory")
#define PG8_WAIT_L(n) asm volatile("s_waitcnt lgkmcnt(" #n ")" ::: "memory")
#define PG8_BAR __builtin_amdgcn_s_barrier()
#define PG8_SCHED __builtin_amdgcn_sched_barrier(0)
    Unit cur, nxt; int ui = 0;
    if (!S.next(0, cur)) return;
    f32x4 acc[2][2][4][2];
#pragma unroll
    for (int a = 0; a < 2; ++a)
#pragma unroll
        for (int b = 0; b < 2; ++b)
#pragma unroll
            for (int m = 0; m < 4; ++m)
#pragma unroll
                for (int n = 0; n < 2; ++n) acc[a][b][m][n] = (f32x4){0.f, 0.f, 0.f, 0.f};
    bf16x8 At[4][2], B0[2][2], B1[2][2];
    const char* cA = (const char*)g.A + (size_t)cur.pm * tstep; const char* cB = (const char*)g.Bt + (size_t)cur.pn * tstep;
    S.a_ready(cur);
    if constexpr (SP2) {
        PG8_STAGE(PG8_SB(0, 0), cB, voffB); PG8_STAGE(PG8_SB(0, 1), cB + hstep, voffB); PG8_STAGE(PG8_SA(0, 0), cA, voffA); PG8_STAGE(PG8_SA(0, 1), cA + hstep, voffA);
        if (wr == 1) PG8_BAR;
        PG8_WAIT_V(2); PG8_BAR;
        PG8_STAGE(PG8_SB(1, 0), cB + kstep, voffB); PG8_STAGE(PG8_SA(1, 0), cA + kstep, voffA); PG8_STAGE(PG8_SB(1, 1), cB + hstep + kstep, voffB);
        PG8_WAIT_V(6); PG8_BAR;
    } else {
        PG8_STAGE(PG8_SB(0, 0), cB, voffB); PG8_STAGE(PG8_SA(0, 0), cA, voffA); PG8_STAGE(PG8_SB(0, 1), cB + hstep, voffB); PG8_STAGE(PG8_SA(0, 1), cA + hstep, voffA);
        if (wr == 1) PG8_BAR;
        PG8_WAIT_V(4); PG8_BAR;
        PG8_STAGE(PG8_SB(1, 0), cB + kstep, voffB); PG8_STAGE(PG8_SA(1, 0), cA + kstep, voffA); PG8_STAGE(PG8_SB(1, 1), cB + hstep + kstep, voffB);
        PG8_WAIT_V(6); PG8_BAR;
    }
    for (;;) {
        const bool has_next = S.next(ui + 1, nxt);
        const char* nA = has_next ? (const char*)g.A + (size_t)nxt.pm * tstep : cA; const char* nB = has_next ? (const char*)g.Bt + (size_t)nxt.pn * tstep : cB;
        for (int t = 0; t < nt; t += 2) {
            const bool last = (t == nt - 2);
            const char* a1 = cA + (size_t)(t + 1) * kstep;
            const char* a2 = last ? nA : cA + (size_t)(t + 2) * kstep; const char* b2 = last ? nB : cB + (size_t)(t + 2) * kstep;
            const char* a3 = a2 + kstep; const char* b3 = b2 + kstep;
            if (last && has_next) S.a_ready(nxt);
            if constexpr (SP2) {
            PG8_LDB(B0, 0, 0); PG8_LDB(B1, 0, 1); PG8_SCHED; PG8_LDA(At, 0, 0); PG8_STAGE(PG8_SA(1, 1), a1 + hstep, voffA);
            PG8_WAIT_V(8); PG8_WAIT_L(0); PG8_BAR; PG8_MMA(0, 0, At, B0); PG8_MMA(0, 1, At, B1); PG8_BAR; PG8_SCHED;
            PG8_LDA(At, 0, 1); PG8_STAGE(PG8_SB(0, 0), b2, voffB); PG8_STAGE(PG8_SB(0, 1), b2 + hstep, voffB); PG8_STAGE(PG8_SA(0, 0), a2, voffA);
            PG8_WAIT_V(8); PG8_WAIT_L(0); PG8_BAR; PG8_MMA(1, 0, At, B0); PG8_MMA(1, 1, At, B1); PG8_BAR; PG8_SCHED;
            PG8_LDB(B0, 1, 0); PG8_LDB(B1, 1, 1); PG8_SCHED; PG8_LDA(At, 1, 0); PG8_STAGE(PG8_SA(0, 1), a2 + hstep, voffA);
            PG8_WAIT_V(8); PG8_WAIT_L(0); PG8_BAR; PG8_MMA(0, 0, At, B0); PG8_MMA(0, 1, At, B1); PG8_BAR; PG8_SCHED;
            PG8_LDA(At, 1, 1); PG8_STAGE(PG8_SB(1, 0), b3, voffB); PG8_STAGE(PG8_SB(1, 1), b3 + hstep, voffB); PG8_STAGE(PG8_SA(1, 0), a3, voffA);
            PG8_WAIT_V(8); PG8_WAIT_L(0); PG8_BAR; PG8_MMA(1, 0, At, B0); PG8_MMA(1, 1, At, B1); PG8_BAR; PG8_SCHED;
            } else {
            PG8_LDB(B0, 0, 0); PG8_SCHED; PG8_LDA(At, 0, 0); PG8_STAGE(PG8_SA(1, 1), a1 + hstep, voffA);
            PG8_WAIT_L(8); PG8_BAR; PG8_WAIT_L(0); PG8_MMA(0, 0, At, B0); PG8_BAR; PG8_SCHED;
            PG8_LDB(B1, 0, 1); PG8_STAGE(PG8_SB(0, 0), b2, voffB);
            PG8_BAR; PG8_WAIT_L(0); PG8_MMA(0, 1, At, B1); PG8_BAR;
            PG8_LDA(At, 0, 1); PG8_STAGE(PG8_SA(0, 0), a2, voffA);
            PG8_BAR; PG8_WAIT_L(0); PG8_MMA(1, 0, At, B0); PG8_BAR; PG8_SCHED;
            PG8_STAGE(PG8_SB(0, 1), b2 + hstep, voffB);
            PG8_WAIT_V(6); PG8_BAR; PG8_MMA(1, 1, At, B1); PG8_BAR;
            PG8_LDB(B0, 1, 0); PG8_SCHED; PG8_LDA(At, 1, 0); PG8_STAGE(PG8_SA(0, 1), a2 + hstep, voffA);
            PG8_WAIT_L(8); PG8_BAR; PG8_WAIT_L(0); PG8_MMA(0, 0, At, B0); PG8_BAR; PG8_SCHED;
            PG8_LDB(B1, 1, 1); PG8_STAGE(PG8_SB(1, 0), b3, voffB);
            PG8_BAR; PG8_WAIT_L(0); PG8_MMA(0, 1, At, B1); PG8_BAR;
            PG8_LDA(At, 1, 1); PG8_STAGE(PG8_SA(1, 0), a3, voffA);
            PG8_BAR; PG8_WAIT_L(0); PG8_MMA(1, 0, At, B0); PG8_BAR; PG8_SCHED;
            PG8_STAGE(PG8_SB(1, 1), b3 + hstep, voffB);
            PG8_WAIT_V(6); PG8_BAR; PG8_MMA(1, 1, At, B1); PG8_BAR;
            }
        }
        if constexpr (ALIGN_EPI) { if (wr == 0) PG8_BAR; }
        if constexpr (!Epi::AFTER_DRAIN) { E(acc, cur, wr, wc, fr, fq); S.done(cur); }
        if (!has_next) break;
#pragma unroll
        for (int a = 0; a < 2; ++a)
#pragma unroll
            for (int b = 0; b < 2; ++b)
#pragma unroll
                for (int m = 0; m < 4; ++m)
#pragma unroll
                    for (int n = 0; n < 2; ++n) acc[a][b][m][n] = (f32x4){0.f, 0.f, 0.f, 0.f};
        cur = nxt; cA = nA; cB = nB; ++ui;
        if constexpr (ALIGN_EPI) { if (wr == 1) PG8_BAR; }
    }
    PG8_WAIT_V(0);
    if constexpr (!ALIGN_EPI) { if (wr == 0) PG8_BAR; }
    PG8_BAR;
    if constexpr (Epi::AFTER_DRAIN) { E.fused(acc, cur, wr, wc, fr, fq, lds, wid, lane); S.done(cur); }
#undef PG8_SA
#undef PG8_SB
#undef PG8_STAGE
#undef PG8_LDA
#undef PG8_LDB
#undef PG8_MMA
#undef PG8_WAIT_V
#undef PG8_WAIT_L
#undef PG8_BAR
#undef PG8_SCHED
}
}
constexpr int NWAVES = 8;
constexpr int DM = 2048, BATCH = 8, SEQ = 2048, M = BATCH * SEQ, DEPTH = 2, MEM_LEN = 256, MM = BATCH * MEM_LEN;
constexpr int NIN = 6144, HD = 128, CHUNK = 128;
constexpr int C_UA = 0, C_VA = 1024, C_ZA = 2048, C_QB = 3072, C_KB = 3584, C_VB = 4096, C_ZB = 4608, C_QC = 5120, C_ZC = 5632;
constexpr float EPS = 1e-6f;
constexpr size_t MiB = 1u << 20;
constexpr size_t WS_WIN = 2 * MiB;
constexpr size_t WS_WOUT = 50 * MiB;
constexpr size_t WS_WKV = 66 * MiB;
constexpr size_t WS_SGUW = 74 * MiB;
constexpr size_t WS_ROWSS0 = 75 * MiB;
constexpr size_t WS_ROWSS1 = WS_ROWSS0 + 65536;
constexpr size_t WS_MEMRS = WS_ROWSS1 + 65536;
constexpr size_t WS_LNST = WS_MEMRS + 8192;
constexpr size_t WS_MEMB = 76 * MiB;
constexpr size_t WS_MEMKV = 84 * MiB;
constexpr size_t WS_XB = 92 * MiB;
constexpr size_t WS_Y = 156 * MiB;
constexpr size_t WS_PROJ = 220 * MiB;
constexpr size_t WS_END = 412 * MiB;
constexpr int LDS_BYTES = 163840;
constexpr int MISC_OFF = LDS_BYTES - 512;
constexpr int VP = 320;

#define LAS __attribute__((address_space(3)))
typedef unsigned short bf16;
typedef unsigned v4u __attribute__((ext_vector_type(4)));
typedef unsigned v2u __attribute__((ext_vector_type(2)));
typedef float f32x4 __attribute__((ext_vector_type(4)));
typedef float f32x16 __attribute__((ext_vector_type(16)));
typedef short bf16x8 __attribute__((ext_vector_type(8)));
typedef short s16x4 __attribute__((ext_vector_type(4)));
#define MFMA32(a, b, c) __builtin_amdgcn_mfma_f32_32x32x16_bf16((a), (b), (c), 0, 0, 0)
#define LDS_WAIT() asm volatile("s_waitcnt lgkmcnt(0)" ::: "memory")

__device__ __forceinline__ unsigned pk2(float lo, float hi) { return pg8::cvt_pk_bf16(lo, hi); }
__device__ __forceinline__ float bflo(unsigned u) { return __uint_as_float(u << 16); }
__device__ __forceinline__ float bfhi(unsigned u) { return __uint_as_float(u & 0xffff0000u); }
__device__ __forceinline__ float swap_add(float v) { auto rr = __builtin_amdgcn_permlane32_swap(__float_as_uint(v), __float_as_uint(v), false, false); return __uint_as_float(rr[0]) + __uint_as_float(rr[1]); }
__device__ __forceinline__ float swap_max(float v) { auto rr = __builtin_amdgcn_permlane32_swap(__float_as_uint(v), __float_as_uint(v), false, false); return fmaxf(__uint_as_float(rr[0]), __uint_as_float(rr[1])); }
__device__ __forceinline__ float wave_sum(float v) {
#pragma unroll
    for (int o = 1; o < 64; o <<= 1) v += __shfl_xor(v, o);
    return v;
}
__device__ __forceinline__ s16x4 trread(LAS const unsigned char* p) { return __builtin_bit_cast(s16x4, __builtin_amdgcn_ds_read_tr16_b64_v4i16((LAS s16x4*)p)); }
__device__ __forceinline__ bf16x8 vfrag(LAS const unsigned char* vl, int off) {
    const s16x4 lo = trread(vl + off), hi = trread(vl + off + 8 * VP);
    return (bf16x8){lo[0], lo[1], lo[2], lo[3], hi[0], hi[1], hi[2], hi[3]};
}
__device__ __forceinline__ int vlane_off(int lane) { return ((lane >> 4) & 1) * 32 + (lane & 3) * 8 + (4 * (lane >> 5) + ((lane & 15) >> 2)) * VP; }
__device__ __forceinline__ bf16x8 packfrag(const f32x16& p, int s) {
    v4u w; w.x = pk2(p[8 * s + 0], p[8 * s + 1]); w.y = pk2(p[8 * s + 2], p[8 * s + 3]); w.z = pk2(p[8 * s + 4], p[8 * s + 5]); w.w = pk2(p[8 * s + 6], p[8 * s + 7]);
    return __builtin_bit_cast(bf16x8, w);
}

typedef __attribute__((address_space(1))) unsigned gu32;
#define XB_TMO      128
#define XB_XCNT(j)  (256  + 64 * (j))
#define XB_XSUB(j)  (1280 + 64 * (j))
#define XB_XGEN(j)  (2304 + 64 * (j))
#define XB_TOP      3328
#define XB_TOPGEN   3392
#define XCD_BAR_WORDS 3456
#define XB_SPIN_CAP (1u << 18)

__device__ __forceinline__ unsigned xb_ld(unsigned* p)              { return __hip_atomic_load(p, __ATOMIC_RELAXED, __HIP_MEMORY_SCOPE_AGENT); }
__device__ __forceinline__ unsigned xb_add(unsigned* p, unsigned v) { return __hip_atomic_fetch_add(p, v, __ATOMIC_RELAXED, __HIP_MEMORY_SCOPE_AGENT); }
__device__ __forceinline__ unsigned xb_xcc_id() { return (unsigned)__builtin_amdgcn_s_getreg((3 << 11) | 20) & 0xFu; }
#define XB_SPIN(cond, bar) do { unsigned _sp = 0; while (cond) { __builtin_amdgcn_s_sleep(1); \
    if ((++_sp & 255u) == 0u) { if (xb_ld(&(bar)[XB_TMO])) break; if (_sp > XB_SPIN_CAP) { atomicAdd(&(bar)[XB_TMO], 1u); break; } } } } while (0)

struct XcdBarrier {
    unsigned* bar; unsigned x;
    volatile LAS unsigned* st;
};

__device__ __forceinline__ XcdBarrier xcd_barrier_post(unsigned* bar, volatile LAS unsigned* st) {
    XcdBarrier b; b.bar = bar; b.x = xb_xcc_id(); b.st = st;
    if (threadIdx.x == 0) (void)xb_add(&bar[XB_XCNT(b.x)], 1u);
    return b;
}
__device__ __forceinline__ void xcd_barrier_complete(unsigned* bar, unsigned x, unsigned& nloc, unsigned& nx, unsigned G) {
    unsigned sum, cnt, mine, sp = 0u;
    for (;;) {
        sum = 0u; cnt = 0u; mine = 0u;
#pragma unroll
        for (unsigned j = 0; j < 16; ++j) { const unsigned c = xb_ld(&bar[XB_XCNT(j)]); sum += c; cnt += (c > 0u) ? 1u : 0u; mine = (j == x) ? c : mine; }
        if (sum == G) break;
        __builtin_amdgcn_s_sleep(1);
        if ((++sp & 255u) == 0u) { if (xb_ld(&bar[XB_TMO])) break; if (sp > XB_SPIN_CAP) { atomicAdd(&bar[XB_TMO], 1u); break; } }
    }
    nloc = mine > 0u ? mine : 1u; nx = cnt > 0u ? cnt : 1u;
}

__device__ __forceinline__ void xcd_barrier(const XcdBarrier& b, bool t0, unsigned Gtot) {
    asm volatile("s_waitcnt vmcnt(0)" ::: "memory");
    __syncthreads();
    if (t0) {
        unsigned* bar = b.bar;
        __builtin_amdgcn_s_waitcnt(0);
        unsigned nloc = b.st[0], nx = b.st[1];
        if (nloc == 0u) { xcd_barrier_complete(bar, b.x, nloc, nx, Gtot); b.st[0] = nloc; b.st[1] = nx; }
        const unsigned old = xb_add(&bar[XB_XSUB(b.x)], 1u);
        const unsigned gen = old / nloc;
        if (old + 1u == (gen + 1u) * nloc) {
            __builtin_amdgcn_fence(__ATOMIC_RELEASE, "agent");
            asm volatile("s_waitcnt vmcnt(0)" ::: "memory");
            const unsigned og = xb_add(&bar[XB_TOP], 1u);
            const unsigned tg = og / nx;
            if (og + 1u == (tg + 1u) * nx) xb_add(&bar[XB_TOPGEN], 1u);
            else XB_SPIN(xb_ld(&bar[XB_TOPGEN]) == tg, bar);
            __builtin_amdgcn_fence(__ATOMIC_ACQUIRE, "agent");
            xb_add(&bar[XB_XGEN(b.x)], 1u);
            asm volatile("s_waitcnt vmcnt(0)" ::: "memory");
        } else {
            XB_SPIN(xb_ld(&bar[XB_XGEN(b.x)]) == gen, bar);
            __builtin_amdgcn_fence(__ATOMIC_ACQUIRE, "agent");
            asm volatile("s_waitcnt vmcnt(0)" ::: "memory");
        }
    }
    __syncthreads();
}

struct Args { const float* in[13]; float* out; unsigned char* ws; };
__device__ __forceinline__ Args load_args() {
    typedef __attribute__((address_space(4))) const unsigned long long* kptr_t;
    kptr_t kp = (kptr_t)__builtin_amdgcn_kernarg_segment_ptr();
    asm volatile("" : "+s"(kp));
    Args a;
#pragma unroll
    for (int k = 0; k < 13; ++k) a.in[k] = (const float*)kp[k];
    a.out = (float*)kp[13]; a.ws = (unsigned char*)kp[14];
    return a;
}
__device__ __forceinline__ int lane_id() { return (int)__builtin_amdgcn_mbcnt_hi(~0u, __builtin_amdgcn_mbcnt_lo(~0u, 0u)); }

__device__ __forceinline__ void p0_transpose_item(const float* W, const float* g, int K, int N, bf16* WT, int row_off, int item, int lane) {
    const int nblk = N / 64, kb = item / nblk, nb = item % nblk, k0 = 64 * kb, n0 = 64 * nb;
    const float* src = W + (size_t)k0 * N + n0 + lane; float v[64];
#pragma unroll
    for (int j = 0; j < 64; ++j) v[j] = __builtin_nontemporal_load(src + (size_t)j * N);
    if (g) {
#pragma unroll
        for (int j = 0; j < 64; ++j) v[j] *= g[k0 + j]; }
    bf16* dst = WT + (size_t)(row_off + n0 + lane) * K + k0;
#pragma unroll
    for (int c = 0; c < 8; ++c) { v4u o; o.x = pk2(v[8 * c], v[8 * c + 1]); o.y = pk2(v[8 * c + 2], v[8 * c + 3]); o.z = pk2(v[8 * c + 4], v[8 * c + 5]); o.w = pk2(v[8 * c + 6], v[8 * c + 7]); *(v4u*)(dst + 8 * c) = o; }
}
__device__ __forceinline__ float row_to_bf16(const float* xrow, bf16* orow, int lane) {
    const f32x4* xr = (const f32x4*)xrow + lane; f32x4 v[8]; float s = 0.f;
#pragma unroll
    for (int j = 0; j < 8; ++j) { v[j] = __builtin_nontemporal_load(xr + 64 * j); s += (v[j].x * v[j].x + v[j].y * v[j].y) + (v[j].z * v[j].z + v[j].w * v[j].w); }
    v2u* o8 = (v2u*)orow + lane;
#pragma unroll
    for (int j = 0; j < 8; ++j) { v2u w; w.x = pk2(v[j].x, v[j].y); w.y = pk2(v[j].z, v[j].w); o8[64 * j] = w; }
    return wave_sum(s);
}

__device__ __forceinline__ void p0_common(const Args& a, int tid, int lane, int wave, int G, int grp, int lb, int GB) {
    unsigned char* ws = a.ws;
    { const int gw = blockIdx.x * NWAVES + wave, NGW = G * NWAVES; constexpr int I_IN = (DM / 64) * (NIN / 64);
      for (int it = gw; it < I_IN; it += NGW) p0_transpose_item(a.in[3], a.in[2], DM, NIN, (bf16*)(ws + WS_WIN), 0, it, lane); }
    { const int gw = lb * NWAVES + wave, NGW = GB * NWAVES; const int m0 = grp * (M / 2); float* rowss0 = (float*)(ws + WS_ROWSS0);
      for (int m = m0 + gw; m < m0 + M / 2; m += NGW) { const float ss = row_to_bf16(a.in[0] + (size_t)m * DM, (bf16*)(ws + WS_XB) + (size_t)m * DM, lane); if (lane == 0) rowss0[m] = ss; } }
    const int gt = blockIdx.x * (NWAVES * 64) + tid, NGT = G * NWAVES * 64;
    for (int i = gt; i < M / 4; i += NGT) ((f32x4*)(ws + WS_ROWSS1))[i] = (f32x4){0.f, 0.f, 0.f, 0.f};
    for (int i = gt; i < DEPTH * M * 2 / 4; i += NGT) ((f32x4*)(ws + WS_LNST))[i] = (f32x4){0.f, 0.f, 0.f, 0.f};
}
__device__ __forceinline__ void p0_memside(const Args& a, int tid, int lane, int wave, int vb, int NB) {
    unsigned char* ws = a.ws;
    const int gw = vb * NWAVES + wave, NGW = NB * NWAVES;
    constexpr int I_KV = (DM / 64) * (1024 / 64);
    for (int it = gw; it < DEPTH * I_KV; it += NGW) { const int l = it / I_KV, r = it - l * I_KV;
        p0_transpose_item(a.in[9] + (size_t)l * DM * 1024, a.in[8] + l * DM, DM, 1024, (bf16*)(ws + WS_WKV), l * 1024, r, lane); }
    float* memrs = (float*)(ws + WS_MEMRS);
    for (int m = gw; m < MM; m += NGW) { const float ss = row_to_bf16(a.in[1] + (size_t)m * DM, (bf16*)(ws + WS_MEMB) + (size_t)m * DM, lane); if (lane == 0) memrs[m] = __builtin_amdgcn_rsqf(ss * (1.0f / DM) + EPS); }
    const int gt = vb * (NWAVES * 64) + tid, NGT = NB * NWAVES * 64;
    for (int i = gt; i < DEPTH * 8 * 128 * 128 / 4; i += NGT) { const f32x4 w = ((const f32x4*)a.in[6])[i]; const int e = i * 4, s = e & 127, t = (e >> 7) & 127;
        v2u o; o.x = pk2(s <= t ? w.x : 0.f, s + 1 <= t ? w.y : 0.f); o.y = pk2(s + 2 <= t ? w.z : 0.f, s + 3 <= t ? w.w : 0.f); ((v2u*)(ws + WS_SGUW))[i] = o; }
}
__device__ __forceinline__ void p0_late_weights(const Args& a, int lane, int wave, int vb, int NB) {
    unsigned char* ws = a.ws;
    const int gw = vb * NWAVES + wave, NGW = NB * NWAVES;
    constexpr int I_IN = (DM / 64) * (NIN / 64), I_OUT = (DM / 64) * (DM / 64), NQ = I_OUT + I_IN + I_OUT;
    for (int it = gw; it < NQ; it += NGW) {
        if (it < I_OUT) p0_transpose_item(a.in[12], nullptr, DM, DM, (bf16*)(ws + WS_WOUT), 0, it, lane);
        else if (it < I_OUT + I_IN) p0_transpose_item(a.in[3] + (size_t)DM * NIN, a.in[2] + DM, DM, NIN, (bf16*)(ws + WS_WIN) + (size_t)NIN * DM, 0, it - I_OUT, lane);
        else p0_transpose_item(a.in[12] + (size_t)DM * DM, nullptr, DM, DM, (bf16*)(ws + WS_WOUT) + (size_t)DM * DM, 0, it - I_OUT - I_IN, lane);
    }
}

struct ARaw { v4u v[4], u[4], z[4]; float s1[4], s2[4]; };
__device__ __forceinline__ void mixer_a_load_v(const Args& a, int l, int item, int tid, ARaw& R) {
    const unsigned char* ws = a.ws; const bf16* proj = (const bf16*)(ws + WS_PROJ); const float* lnst = (const float*)(ws + WS_LNST) + (size_t)l * M * 2;
    const int g = item & 7, c = (item >> 3) & 15, b = item >> 7; const int tok0 = b * SEQ + c * CHUNK;
#pragma unroll
    for (int i = 0; i < 4; ++i) { const int row = (i * 512 + tid) >> 4, ch = tid & 15; const size_t tok = (size_t)(tok0 + row);
        R.v[i] = __builtin_nontemporal_load((const v4u*)(proj + tok * NIN + C_VA + g * 128 + ch * 8)); R.s1[i] = lnst[2 * tok]; R.s2[i] = lnst[2 * tok + 1]; }
}
__device__ __forceinline__ void mixer_a_load_uz(const Args& a, int item, int tid, ARaw& R) {
    const unsigned char* ws = a.ws; const bf16* proj = (const bf16*)(ws + WS_PROJ);
    const int g = item & 7, c = (item >> 3) & 15, b = item >> 7; const int tok0 = b * SEQ + c * CHUNK;
#pragma unroll
    for (int i = 0; i < 4; ++i) { const int row = (i * 512 + tid) >> 4, ch = tid & 15; const size_t tok = (size_t)(tok0 + row);
        R.u[i] = __builtin_nontemporal_load((const v4u*)(proj + tok * NIN + C_UA + g * 128 + ch * 8)); R.z[i] = __builtin_nontemporal_load((const v4u*)(proj + tok * NIN + C_ZA + g * 128 + ch * 8)); }
}
__device__ __forceinline__ void mixer_a_all(const Args& a, int l, LAS unsigned char* lds, int tid, int lane, int wave, int item0, int NITEM, int G) {
    unsigned char* ws = a.ws; bf16* Y = (bf16*)(ws + WS_Y);
    constexpr int OPP = 528;
    LAS unsigned char* ot = lds + 128 * VP;
    int item = item0; if (item >= NITEM) return;
    ARaw R; mixer_a_load_v(a, l, item, tid, R); mixer_a_load_uz(a, item, tid, R);
    const int r32 = lane & 31, h = lane >> 5, tb = wave >> 1, dh = wave & 1;
    LAS const unsigned char* vl = lds + vlane_off(lane);
    const int g = item & 7;
    const float* lng = a.in[4] + l * 1024 + g * 128 + (tid & 15) * 8; const float* lnb = a.in[5] + l * 1024 + g * 128 + (tid & 15) * 8;
    const f32x4 g0 = *(const f32x4*)(lng), g1 = *(const f32x4*)(lng + 4), b0 = *(const f32x4*)(lnb), b1 = *(const f32x4*)(lnb + 4);
    const bf16* W = (const bf16*)(ws + WS_SGUW) + ((size_t)(l * 8 + g) * 128 + 32 * tb + r32) * 128;
    bf16x8 wf[8];
#pragma unroll
    for (int s = 0; s < 8; ++s) { const v2u wlo = *(const v2u*)(W + 16 * s + 4 * h), whi = *(const v2u*)(W + 16 * s + 8 + 4 * h); wf[s] = __builtin_bit_cast(bf16x8, (v4u){wlo.x, wlo.y, whi.x, whi.y}); }
    float bvs[4];
#pragma unroll
    for (int i = 0; i < 4; ++i) bvs[i] = a.in[7][(size_t)(l * 8 + g) * 128 + ((i * 512 + tid) >> 4)];
    for (; item < NITEM; item += G) {
        const int c = (item >> 3) & 15, b = item >> 7; const int tok0 = b * SEQ + c * CHUNK;
        {
#pragma unroll
          for (int i = 0; i < 4; ++i) { const int row = (i * 512 + tid) >> 4, ch = tid & 15; const v4u raw = R.v[i];
            const float mean = R.s1[i] * (1.0f / 1024), var = R.s2[i] * (1.0f / 1024) - mean * mean; const float rstd = __builtin_amdgcn_rsqf(fmaxf(var, 0.f) + EPS);
            v4u o; o.x = pk2((bflo(raw.x) - mean) * rstd * g0.x + b0.x, (bfhi(raw.x) - mean) * rstd * g0.y + b0.y); o.y = pk2((bflo(raw.y) - mean) * rstd * g0.z + b0.z, (bfhi(raw.y) - mean) * rstd * g0.w + b0.w);
            o.z = pk2((bflo(raw.z) - mean) * rstd * g1.x + b1.x, (bfhi(raw.z) - mean) * rstd * g1.y + b1.y); o.w = pk2((bflo(raw.w) - mean) * rstd * g1.z + b1.z, (bfhi(raw.w) - mean) * rstd * g1.w + b1.w);
            *(LAS v4u*)(lds + row * VP + ch * 16) = o; } }
        __syncthreads();
        const int nitem = item + G;
        if (nitem < NITEM) mixer_a_load_v(a, l, nitem, tid, R);
        f32x16 o0 = {}, o1 = {};
#pragma unroll
        for (int s = 0; s < 8; ++s) if (s < 2 * tb + 2) {
            o0 = MFMA32(wf[s], vfrag(vl, 16 * s * VP + (dh * 2 + 0) * 64), o0);
            o1 = MFMA32(wf[s], vfrag(vl, 16 * s * VP + (dh * 2 + 1) * 64), o1); }
#pragma unroll
        for (int r = 0; r < 16; ++r) { LAS unsigned char* p = ot + (32 * tb + (r & 3) + 8 * (r >> 2) + 4 * h) * OPP + (dh * 64 + r32) * 4; *(LAS float*)p = o0[r]; *(LAS float*)(p + 128) = o1[r]; }
        __syncthreads();
#pragma unroll
        for (int i = 0; i < 4; ++i) { const int row = (i * 512 + tid) >> 4, ch = tid & 15; const float bv = bvs[i];
            const f32x4 m0 = *(LAS const f32x4*)(ot + row * OPP + ch * 32), m1 = *(LAS const f32x4*)(ot + row * OPP + ch * 32 + 16);
            const v4u u = R.u[i], z = R.z[i]; v4u w;
            w.x = pk2((m0.x + bv) * bflo(u.x) * bflo(z.x), (m0.y + bv) * bfhi(u.x) * bfhi(z.x)); w.y = pk2((m0.z + bv) * bflo(u.y) * bflo(z.y), (m0.w + bv) * bfhi(u.y) * bfhi(z.y));
            w.z = pk2((m1.x + bv) * bflo(u.z) * bflo(z.z), (m1.y + bv) * bfhi(u.z) * bfhi(z.z)); w.w = pk2((m1.z + bv) * bflo(u.w) * bflo(z.w), (m1.w + bv) * bfhi(u.w) * bfhi(z.w));
            *(v4u*)(Y + (size_t)(tok0 + row) * DM + g * 128 + ch * 8) = w; }
        if (nitem < NITEM) mixer_a_load_uz(a, nitem, tid, R);
    }
    __syncthreads();
}

__device__ __forceinline__ void out_stage(const f32x16 (&o)[4], LAS unsigned char* scr, const bf16* gate, bf16* y, int lane) {
    const int r32 = lane & 31, h = lane >> 5; constexpr int OP = 272;
    v4u zgs[2][4];
#pragma unroll
    for (int half = 0; half < 2; ++half)
#pragma unroll
        for (int i = 0; i < 4; ++i) zgs[half][i] = *(const v4u*)(gate + (size_t)((i * 64 + lane) >> 3) * NIN + half * 64 + (lane & 7) * 8);
#pragma unroll
    for (int half = 0; half < 2; ++half) {
#pragma unroll
        for (int d2 = 0; d2 < 2; ++d2)
#pragma unroll
            for (int r = 0; r < 16; ++r) *(LAS float*)(scr + ((r & 3) + 8 * (r >> 2) + 4 * h) * OP + (d2 * 32 + r32) * 4) = o[2 * half + d2][r];
#pragma unroll
        for (int i = 0; i < 4; ++i) { const int row = (i * 64 + lane) >> 3, c8 = lane & 7;
            const f32x4 a = *(LAS const f32x4*)(scr + row * OP + c8 * 32), b = *(LAS const f32x4*)(scr + row * OP + c8 * 32 + 16);
            const v4u zg = zgs[half][i];
            v4u w; w.x = pk2(a.x * bflo(zg.x), a.y * bfhi(zg.x)); w.y = pk2(a.z * bflo(zg.y), a.w * bfhi(zg.y)); w.z = pk2(b.x * bflo(zg.z), b.y * bfhi(zg.z)); w.w = pk2(b.z * bflo(zg.w), b.w * bfhi(zg.w));
            *(v4u*)(y + (size_t)row * DM + half * 64 + c8 * 8) = w; }
    }
}
__device__ __forceinline__ void mixer_b(const Args& a, int item, LAS unsigned char* lds, int lane, int wave) {
    unsigned char* ws = a.ws; const bf16* proj = (const bf16*)(ws + WS_PROJ); bf16* Y = (bf16*)(ws + WS_Y);
    const int qb = item & 7, hh = (item >> 3) & 3, b = item >> 5; const int tb = b * SEQ; const int q0 = qb * 256 + wave * 32;
    const int r32 = lane & 31, h = lane >> 5;
    constexpr int QP = 272;
    LAS unsigned char* wv = lds + wave * (32 * 256 + 32 * QP); LAS unsigned char* wq = wv + 32 * 256;
#pragma unroll
    for (int i = 0; i < 8; ++i) { const int idx = i * 64 + lane; *(LAS v4u*)(wq + (idx >> 4) * QP + (idx & 15) * 16) = *(const v4u*)(proj + (size_t)(tb + q0 + (idx >> 4)) * NIN + C_QB + hh * HD + (idx & 15) * 8); }
    LAS const unsigned char* qrd = wq + r32 * QP + h * 16;
    f32x16 o[4]; o[0] = f32x16{}; o[1] = f32x16{}; o[2] = f32x16{}; o[3] = f32x16{};
    float R = 0.f; const int ktd = q0 >> 5;
    const unsigned koff = (unsigned)((r32 * NIN + C_KB + hh * HD + 8 * h) * 2);
    const unsigned voff = (unsigned)(((lane >> 4) * NIN + C_VB + hh * HD + (((lane & 15) ^ (4 * ((lane >> 4) & 3))) * 8)) * 2);
#define B_DMA_V(kt_) do { const char* _g = (const char*)proj + ((size_t)tb + 32 * (kt_)) * (NIN * 2); _Pragma("unroll") for (int _i = 0; _i < 8; ++_i) \
        __builtin_amdgcn_global_load_lds((const unsigned*)(_g + (size_t)(4 * _i) * (NIN * 2) + voff), (LAS unsigned*)(wv + _i * 1024), 16, 0, 0); } while (0)
    const int sw = (lane & 15) >> 2;
    LAS const unsigned char* vl = wv + (4 * h + sw) * 256 + ((lane >> 4) & 1) * 32 + (lane & 3) * 8;
    bf16x8 kf[8];
#pragma unroll
    for (int s = 0; s < 8; ++s) kf[s] = *(const bf16x8*)((const char*)proj + ((size_t)tb + 32 * ktd) * (NIN * 2) + koff + 32 * s);
    for (int kt = ktd; kt >= 0; --kt) {
        f32x16 z = {};
#pragma unroll
        for (int s = 0; s < 8; ++s) z = MFMA32(kf[s], *(LAS const bf16x8*)(qrd + 32 * s), z);
        asm volatile("" : "+v"(z) :: "memory");
        __builtin_amdgcn_sched_barrier(0);
        { const char* nb = (const char*)proj + ((size_t)tb + 32 * (kt > 0 ? kt - 1 : 0)) * (NIN * 2);
#pragma unroll
          for (int s = 0; s < 8; ++s) kf[s] = *(const bf16x8*)(nb + koff + 32 * s); }
        B_DMA_V(kt);
        const bool diag = (kt == ktd);
        f32x16 lb, l1; float tsum = 0.f;
#pragma unroll
        for (int r = 0; r < 16; ++r) { const float zz = z[r]; const float e = __builtin_amdgcn_exp2f(-fabsf(zz)); const float lp = __builtin_amdgcn_logf(1.0f + e);
            const float lbv = fminf(zz, 0.f) - lp; const int key = (r & 3) + 8 * (r >> 2) + 4 * h; const bool valid = !diag || key < r32;
            lb[r] = valid ? lbv : -1e30f; const float lv = valid ? (lbv - zz) : 0.f; l1[r] = lv; tsum += lv; }
        bf16x8 hf0, hf1, lf0, lf1;
        { v4u H0, H1, L0, L1;
#pragma unroll
          for (int p = 0; p < 4; ++p) { const unsigned u0 = pk2(l1[2 * p], l1[2 * p + 1]), u1 = pk2(l1[8 + 2 * p], l1[8 + 2 * p + 1]);
              H0[p] = u0; H1[p] = u1; L0[p] = pk2(l1[2 * p] - bflo(u0), l1[2 * p + 1] - bfhi(u0)); L1[p] = pk2(l1[8 + 2 * p] - bflo(u1), l1[8 + 2 * p + 1] - bfhi(u1)); }
          hf0 = __builtin_bit_cast(bf16x8, H0); hf1 = __builtin_bit_cast(bf16x8, H1); lf0 = __builtin_bit_cast(bf16x8, L0); lf1 = __builtin_bit_cast(bf16x8, L1); }
        bf16x8 T0, T1;
        { int ro = r32 - 4 * h; asm volatile("" : "+v"(ro));
#pragma unroll
          for (int j = 0; j < 8; ++j) { const int k = 8 * (j >> 2) + (j & 3); T0[j] = (k > ro) ? (short)0x3F80 : (short)0; T1[j] = (16 + k > ro) ? (short)0x3F80 : (short)0; } }
        f32x16 cs = {};
        cs = MFMA32(T0, hf0, cs); cs = MFMA32(T1, hf1, cs); cs = MFMA32(T0, lf0, cs); cs = MFMA32(T1, lf1, cs);
        f32x16 p;
#pragma unroll
        for (int r = 0; r < 16; ++r) p[r] = __builtin_amdgcn_exp2f(lb[r] + cs[r] + R);
        const bf16x8 pa0 = packfrag(p, 0), pa1 = packfrag(p, 1);
        R += swap_add(tsum);
        asm volatile("s_waitcnt vmcnt(0)" ::: "memory");
#pragma unroll
        for (int d = 0; d < 4; ++d) { const int go = ((d ^ sw) * 64);
            const s16x4 a0 = trread(vl + go), a1 = trread(vl + go + 8 * 256), b0 = trread(vl + go + 16 * 256), b1 = trread(vl + go + 24 * 256);
            o[d] = MFMA32(pa0, ((bf16x8){a0[0], a0[1], a0[2], a0[3], a1[0], a1[1], a1[2], a1[3]}), o[d]);
            o[d] = MFMA32(pa1, ((bf16x8){b0[0], b0[1], b0[2], b0[3], b1[0], b1[1], b1[2], b1[3]}), o[d]); }
        const bool stop = (__builtin_amdgcn_ballot_w64(R >= -158.7f) == 0ull) || kt == 0;
        asm volatile("s_waitcnt lgkmcnt(0)" ::: "memory");
        if (stop) break;
    }
#undef B_DMA_V
    out_stage(o, wq, proj + (size_t)(tb + q0) * NIN + C_ZB + hh * HD, Y + (size_t)(tb + q0) * DM + 1024 + hh * HD, lane);
}

__device__ __forceinline__ void mixer_c(const Args& a, int l, int item, LAS unsigned char* lds, int tid, int lane, int wave) {
    unsigned char* ws = a.ws; const bf16* proj = (const bf16*)(ws + WS_PROJ); bf16* Y = (bf16*)(ws + WS_Y); const bf16* kv = (const bf16*)(ws + WS_MEMKV);
    const int qb = item & 7, hh = (item >> 3) & 3, b = item >> 5; const int tb = b * SEQ; const int q0 = qb * 256 + wave * 32;
    const int r32 = lane & 31, h = lane >> 5;
    const bf16* Kb = kv + (size_t)(b * MEM_LEN) * 2048 + l * 1024 + hh * HD; const bf16* Vb = Kb + 512;
    constexpr int KP = 272;
    LAS unsigned char* kt_ = lds + 256 * VP;
    LAS float* rkl = (LAS float*)(lds + 256 * VP + 256 * KP); LAS float* lw = rkl + 256 + wave * 32;
    LAS float* gkl = rkl + 256 + 8 * 32;
    v4u qraw[8];
#pragma unroll
    for (int s = 0; s < 8; ++s) qraw[s] = *(const v4u*)(proj + (size_t)(tb + q0 + r32) * NIN + C_QC + hh * HD + 16 * s + 8 * h);
    if (tid < HD) gkl[tid] = a.in[10][l * HD + tid] * a.in[11][l * HD + tid];
#pragma unroll
    for (int i = 0; i < 8; ++i) { const int idx = i * 512 + tid, row = idx >> 4, ch = idx & 15;
        *(LAS v4u*)(lds + row * VP + ch * 16) = *(const v4u*)(Vb + (size_t)row * 2048 + ch * 8);
        const v4u w = *(const v4u*)(Kb + (size_t)row * 2048 + ch * 8); *(LAS v4u*)(kt_ + row * KP + ch * 16) = w;
        float ss = (bflo(w.x) * bflo(w.x) + bfhi(w.x) * bfhi(w.x)) + (bflo(w.y) * bflo(w.y) + bfhi(w.y) * bfhi(w.y)) + (bflo(w.z) * bflo(w.z) + bfhi(w.z) * bfhi(w.z)) + (bflo(w.w) * bflo(w.w) + bfhi(w.w) * bfhi(w.w));
        ss += __shfl_xor(ss, 1); ss += __shfl_xor(ss, 2); ss += __shfl_xor(ss, 4); ss += __shfl_xor(ss, 8);
        if (ch == 0) rkl[row] = __builtin_amdgcn_rsqf(ss * (1.0f / HD) + EPS); }
    __syncthreads();
    bf16x8 qf[8]; float rq;
    { float ss = 0.f;
#pragma unroll
      for (int s = 0; s < 8; ++s) { const v4u w = qraw[s];
          const f32x4 k0 = *(LAS const f32x4*)(gkl + 16 * s + 8 * h), k1 = *(LAS const f32x4*)(gkl + 16 * s + 8 * h + 4);
          const float x0 = bflo(w.x), x1 = bfhi(w.x), x2 = bflo(w.y), x3 = bfhi(w.y), x4 = bflo(w.z), x5 = bfhi(w.z), x6 = bflo(w.w), x7 = bfhi(w.w);
          ss += (x0 * x0 + x1 * x1) + (x2 * x2 + x3 * x3) + (x4 * x4 + x5 * x5) + (x6 * x6 + x7 * x7);
          v4u o; o.x = pk2(x0 * k0.x, x1 * k0.y); o.y = pk2(x2 * k0.z, x3 * k0.w); o.z = pk2(x4 * k1.x, x5 * k1.y); o.w = pk2(x6 * k1.z, x7 * k1.w);
          qf[s] = __builtin_bit_cast(bf16x8, o); }
      ss = swap_add(ss); rq = __builtin_amdgcn_rsqf(ss * (1.0f / HD) + EPS); }
    LAS const unsigned char* vl = lds + vlane_off(lane);
    LAS const unsigned char* krd = kt_ + r32 * KP + h * 16;
    float mx = -1e30f;
    for (int t8 = 0; t8 < 8; ++t8) {
        f32x16 z = {};
#pragma unroll
        for (int s = 0; s < 8; ++s) z = MFMA32(*(LAS const bf16x8*)(krd + (32 * t8) * KP + 32 * s), qf[s], z);
#pragma unroll
        for (int q = 0; q < 4; ++q) { const f32x4 rk = *(LAS const f32x4*)(rkl + 32 * t8 + 8 * q + 4 * h);
#pragma unroll
            for (int j = 0; j < 4; ++j) mx = fmaxf(mx, z[4 * q + j] * rk[j]); }
    }
    mx = swap_max(mx);
    const float cc = rq * 0.08838834764831845f * 1.4426950408889634f;
    f32x16 o[4]; o[0] = f32x16{}; o[1] = f32x16{}; o[2] = f32x16{}; o[3] = f32x16{};
    float lsum = 0.f;
    for (int t8 = 0; t8 < 8; ++t8) {
        f32x16 z = {};
#pragma unroll
        for (int s = 0; s < 8; ++s) z = MFMA32(*(LAS const bf16x8*)(krd + (32 * t8) * KP + 32 * s), qf[s], z);
        f32x16 p;
#pragma unroll
        for (int q = 0; q < 4; ++q) { const f32x4 rk = *(LAS const f32x4*)(rkl + 32 * t8 + 8 * q + 4 * h);
#pragma unroll
            for (int j = 0; j < 4; ++j) { const float e = __builtin_amdgcn_exp2f((z[4 * q + j] * rk[j] - mx) * cc); p[4 * q + j] = e; lsum += e; } }
        const bf16x8 pa0 = packfrag(p, 0), pa1 = packfrag(p, 1);
#pragma unroll
        for (int d = 0; d < 4; ++d) { o[d] = MFMA32(pa0, vfrag(vl, (32 * t8) * VP + d * 64), o[d]); o[d] = MFMA32(pa1, vfrag(vl, (32 * t8 + 16) * VP + d * 64), o[d]); }
    }
    lsum = swap_add(lsum);
    if (h == 0) lw[r32] = 1.0f / lsum;
    LDS_WAIT(); asm volatile("" ::: "memory");
#pragma unroll
    for (int q = 0; q < 4; ++q) { const f32x4 li = *(LAS const f32x4*)(lw + 8 * q + 4 * h);
#pragma unroll
        for (int j = 0; j < 4; ++j)
#pragma unroll
            for (int d = 0; d < 4; ++d) o[d][4 * q + j] *= li[j]; }
    __syncthreads();
    out_stage(o, kt_ + wave * (32 * 272), proj + (size_t)(tb + q0) * NIN + C_ZC + hh * HD, Y + (size_t)(tb + q0) * DM + 1536 + hh * HD, lane);
    __syncthreads();
}

constexpr int CW_BAR_ALL = 0, CW_BAR_GRP = XCD_BAR_WORDS  , CW_SUB = 3 * XCD_BAR_WORDS + 64, CW_FLAG = 3 * XCD_BAR_WORDS + 128;
static_assert((CW_FLAG + 64) * 4 <= 65536, "control words inside the per-call memset");

__global__ void __launch_bounds__(NWAVES * 64, 2) fwd_mega(Args args_unused) {
    extern __shared__ __attribute__((aligned(16))) unsigned char lds_raw[];
    LAS unsigned char* lds = (LAS unsigned char*)lds_raw;
    cg::grid_group grid = cg::this_grid();
    const int G = gridDim.x, GB = G >> 1;
    const int grp = ((int)blockIdx.x >= GB) ? 1 : 0, lb = (int)blockIdx.x - grp * GB;
    const int wave_s = __builtin_amdgcn_readfirstlane(threadIdx.x >> 6);
#define IDS() int tid = wave_s * 64 + lane_id(); asm volatile("" : "+v"(tid)); const int lane = tid & 63, wave = wave_s; (void)lane; (void)wave
#define XBAR_ALL() do { XcdBarrier b_; b_.bar = (unsigned*)load_args().ws + CW_BAR_ALL; b_.x = xb_xcc_id(); b_.st = (volatile LAS unsigned*)(lds + MISC_OFF) + 8; xcd_barrier(b_, wave_s == 0 && lane_id() == 0, (unsigned)G); } while (0)
#define XBAR() do { XcdBarrier b_; b_.bar = (unsigned*)load_args().ws + CW_BAR_GRP + grp * XCD_BAR_WORDS; b_.x = xb_xcc_id(); b_.st = (volatile LAS unsigned*)(lds + MISC_OFF) + 10; xcd_barrier(b_, wave_s == 0 && lane_id() == 0, (unsigned)GB); } while (0)
    for (int u = threadIdx.x; u < 128; u += NWAVES * 64) ((LAS unsigned*)(lds + MISC_OFF))[u] = 0u;
    __syncthreads();
    (void)xcd_barrier_post((unsigned*)load_args().ws + CW_BAR_ALL, (volatile LAS unsigned*)(lds + MISC_OFF) + 8);
    (void)xcd_barrier_post((unsigned*)load_args().ws + CW_BAR_GRP + grp * XCD_BAR_WORDS, (volatile LAS unsigned*)(lds + MISC_OFF) + 10);
    constexpr int KVB = 64;
    if (load_args().ws == nullptr) grid.sync();
    { IDS(); const Args args = load_args(); p0_common(args, tid, lane, wave, G, grp, lb, GB); }
    XBAR_ALL();
    if (grp == 1) {
        if (lb < KVB) {
            { IDS(); const Args args = load_args(); p0_memside(args, tid, lane, wave, lb, KVB); }
            {   unsigned* cnt = (unsigned*)load_args().ws + CW_SUB;
                asm volatile("s_waitcnt vmcnt(0)" ::: "memory"); __syncthreads();
                if (wave_s == 0 && lane_id() == 0) {
                    __builtin_amdgcn_fence(__ATOMIC_RELEASE, "agent"); asm volatile("s_waitcnt vmcnt(0)" ::: "memory");
                    (void)xb_add(cnt, 1u);
                    unsigned sp = 0; while (xb_ld(cnt) < (unsigned)KVB) { __builtin_amdgcn_s_sleep(1); if (++sp > (1u << 22)) break; }
                    __builtin_amdgcn_fence(__ATOMIC_ACQUIRE, "agent"); asm volatile("s_waitcnt vmcnt(0)" ::: "memory");
                }
                __syncthreads();
                __builtin_amdgcn_fence(__ATOMIC_ACQUIRE, "agent"); asm volatile("s_waitcnt vmcnt(0)" ::: "memory"); }
            unsigned char* ws = load_args().ws;
            pg8::Gemm g2{(const pg8::bf16_t*)(ws + WS_MEMB), (const pg8::bf16_t*)(ws + WS_WKV), MM, 2048, DM};
            pg8::StaticOrder S2; S2.init(MM, 2048, KVB, lb);
            pg8::EpiKV E2{(pg8::bf16_t*)(ws + WS_MEMKV), 2048, (const float*)(ws + WS_MEMRS)};
            pg8::gemm_phase<pg8::EpiKV, pg8::StaticOrder, true, true>(lds, g2, S2, E2, wave_s);
        } else { IDS(); const Args args = load_args(); p0_late_weights(args, lane, wave, lb - KVB, GB - KVB); }
        XBAR();
        if (lb == 0 && wave_s == 0 && lane_id() == 0) {
            __builtin_amdgcn_fence(__ATOMIC_RELEASE, "agent"); asm volatile("s_waitcnt vmcnt(0)" ::: "memory");
            __hip_atomic_store((unsigned*)load_args().ws + CW_FLAG, 1u, __ATOMIC_RELAXED, __HIP_MEMORY_SCOPE_AGENT); }
    }
    const int row0 = grp * (M / 2);
    for (int l = 0; l < DEPTH; ++l) {
        {
            unsigned char* ws = load_args().ws;
            pg8::Gemm g{(const pg8::bf16_t*)(ws + WS_XB) + (size_t)row0 * DM, (const pg8::bf16_t*)(ws + WS_WIN) + (size_t)l * NIN * DM, M / 2, NIN, DM};
            pg8::StaticOrder S; S.init(M / 2, NIN, GB, lb);
            pg8::EpiIn E{(pg8::bf16_t*)(ws + WS_PROJ) + (size_t)row0 * NIN, NIN, (const float*)(ws + (l == 0 ? WS_ROWSS0 : WS_ROWSS1)) + row0, (float*)(ws + WS_LNST) + (size_t)l * M * 2 + (size_t)row0 * 2, 1.0f / DM, EPS};
            pg8::gemm_phase<pg8::EpiIn, pg8::StaticOrder, true, true>(lds, g, S, E, wave_s);
        }
        XBAR();
        if (l == 0 && grp == 0) {
            if (wave_s == 0 && lane_id() == 0) { unsigned* fl = (unsigned*)load_args().ws + CW_FLAG; unsigned sp = 0;
                while (xb_ld(fl) == 0u) { __builtin_amdgcn_s_sleep(1); if (++sp > (1u << 22)) break; }
                __builtin_amdgcn_fence(__ATOMIC_ACQUIRE, "agent"); asm volatile("s_waitcnt vmcnt(0)" ::: "memory"); }
            __syncthreads();
            __builtin_amdgcn_fence(__ATOMIC_ACQUIRE, "agent"); asm volatile("s_waitcnt vmcnt(0)" ::: "memory");
        }
        {
            IDS(); const Args args = load_args();
            const int sub = (int)((unsigned)(2 * (lb & 7) + (lb >> 6)) % 3u);
            const int a0 = grp * (BATCH * 16 * 8 / 2) + lb, a1 = (grp + 1) * (BATCH * 16 * 8 / 2);
            const int b0 = grp * (BATCH * 4 * 8 / 2) + (2 * (lb & 7) + (lb >> 6)) * 8 + ((lb >> 3) & 7), b1 = b0 + 1;
            if (sub == 0) mixer_a_all(args, l, lds, tid, lane, wave, a0, a1, GB);
            for (int it = b0; it < b1; it += GB) mixer_b(args, it, lds, lane, wave);
            __syncthreads();
            if (sub == 1) mixer_a_all(args, l, lds, tid, lane, wave, a0, a1, GB);
            for (int it = b0; it < b1; it += GB) mixer_c(args, l, it, lds, tid, lane, wave);
            if (sub == 2) mixer_a_all(args, l, lds, tid, lane, wave, a0, a1, GB);
        }
        XBAR();
        {
            const Args a_ = load_args(); unsigned char* ws = a_.ws; const size_t ro = (size_t)row0 * DM;
            pg8::Gemm g{(const pg8::bf16_t*)(ws + WS_Y) + ro, (const pg8::bf16_t*)(ws + WS_WOUT) + (size_t)l * DM * DM, M / 2, DM, DM};
            pg8::StaticOrder S; S.init(M / 2, DM, GB, lb);
            pg8::EpiOut E{nullptr, (const pg8::bf16_t*)(ws + WS_XB) + ro, l == 0 ? nullptr : a_.out + ro, DM, l == 0 ? (pg8::bf16_t*)(ws + WS_XB) + ro : nullptr, (float*)(ws + WS_ROWSS1) + row0};
            pg8::gemm_phase<pg8::EpiOut, pg8::StaticOrder, true, true>(lds, g, S, E, wave_s);
        }
        if (l + 1 < DEPTH) XBAR();
    }
}

extern "C" void kernel_launch(void* const* d_in, const int* in_sizes, int n_in, void* d_out, int out_size, void* d_ws, size_t ws_size, hipStream_t stream) {
    static int grid = 0;
    if (grid == 0) {
        if (n_in != 13 || out_size != M * DM || ws_size < WS_END) { fprintf(stderr, "kernel_launch: unexpected shapes (n_in %d out %d ws %zu)\n", n_in, out_size, ws_size); grid = -1; return; }
        int dev = 0, cus = 0, per_cu = 0;
        hipGetDevice(&dev); hipDeviceGetAttribute(&cus, hipDeviceAttributeMultiprocessorCount, dev);
        hipFuncSetAttribute((const void*)fwd_mega, hipFuncAttributeMaxDynamicSharedMemorySize, LDS_BYTES);
        hipOccupancyMaxActiveBlocksPerMultiprocessor(&per_cu, (const void*)fwd_mega, NWAVES * 64, LDS_BYTES);
        if (per_cu < 1) { fprintf(stderr, "kernel_launch: occupancy query says %d blocks per CU\n", per_cu); per_cu = 1; }
        (void)hipGetLastError();
        grid = cus * per_cu;
        if (grid < 256 || grid % 16 != 0) { fprintf(stderr, "kernel_launch: grid %d too small for this kernel\n", grid); grid = -1; return; }
    }
    if (grid < 0) return;
    Args a{};
    for (int i = 0; i < 13; ++i) a.in[i] = (const float*)d_in[i];
    a.out = (float*)d_out; a.ws = (unsigned char*)d_ws;
    if (hipMemsetAsync(d_ws, 0, 65536, stream) != hipSuccess) { fprintf(stderr, "kernel_launch: memset failed\n"); return; }
    void* kargs[] = {&a};
    hipError_t e = hipLaunchCooperativeKernel((void*)fwd_mega, dim3(grid), dim3(NWAVES * 64), kargs, LDS_BYTES, stream);
    if (e != hipSuccess) fprintf(stderr, "kernel_launch: cooperative launch failed: %s (grid %d)\n", hipGetErrorString(e), grid);
}
```

```cpp
#include <hip/hip_runtime.h>
#include <hip/hip_cooperative_groups.h>
#include <cstdio>
#include <cstdint>
namespace cg = cooperative_groups;
namespace pg8 {
#define PG8_LAS __attribute__((address_space(3)))
typedef unsigned short bf16_t;
typedef short bf16x8 __attribute__((ext_vector_type(8)));
typedef float f32x4 __attribute__((ext_vector_type(4)));
typedef unsigned u32x4 __attribute__((ext_vector_type(4)));
constexpr int BM = 256, BK = 64, HALF = 128, HTB = HALF * BK * 2  , STAGE_BYTES = 8 * HTB, NXCD = 8, WGM = 4;

__host__ __device__ __forceinline__ int lds_byte(int r, int c) { const int st = (r >> 4) * 2 + (c >> 5), rr = r & 15, cc = c & 31, ob = rr * 64 + cc * 2; return st * 1024 + (ob ^ (((ob >> 9) & 1) << 5)); }
__host__ __device__ __forceinline__ void stage_rc(int b, int& R, int& C) { const int st = b / 1024, sb = b % 1024, swz = sb ^ (((sb >> 9) & 1) << 5); R = (st >> 1) * 16 + swz / 64; C = (st & 1) * 32 + (swz % 64) / 2; }
__host__ __device__ __forceinline__ int perm32(int rho) { const int n = rho >> 4, i = rho & 15; return 8 * (i >> 2) + 4 * n + (i & 3); }

struct Unit { int pm, pn; };
struct Gemm { const bf16_t* A; const bf16_t* Bt; int M, N, K; };

struct StaticOrder {
    int nM, nN, nwg, G, c;
    __host__ __device__ void init(int M, int N, int G_, int c_) { nM = M / BM; nN = N / BM; nwg = nM * nN; G = G_; c = c_; }
    __host__ __device__ bool next(int i, Unit& u) const {
        const long L = (long)i * G + c; if (L >= nwg) return false;
        int wgid = (int)L; { const int q = nwg / NXCD, r = nwg % NXCD, xcd = wgid % NXCD, off = wgid / NXCD; wgid = (xcd < r ? xcd * (q + 1) : r * (q + 1) + (xcd - r) * q) + off; }
        const int nig = WGM * nN, gid = wgid / nig, fm = gid * WGM, gsz = (nM - fm) < WGM ? (nM - fm) : WGM;
        u.pm = fm + ((wgid % nig) % gsz); u.pn = (wgid % nig) / gsz; return true;
    }
    __device__ __forceinline__ void a_ready(const Unit&) const {}
    __device__ __forceinline__ void done(const Unit&) const {}
};

__device__ __forceinline__ unsigned cvt_pk_bf16(float lo, float hi) { unsigned r; asm volatile("v_cvt_pk_bf16_f32 %0, %1, %2" : "=v"(r) : "v"(lo), "v"(hi)); return r; }
typedef float f32x2 __attribute__((ext_vector_type(2)));
__device__ __forceinline__ f32x2 gelu_pk(f32x2 v) {
    const f32x2 av = __builtin_elementwise_abs(v), d = av * 0.2316418882f + 1.0f;
    f32x2 t; t.x = __builtin_amdgcn_rcpf(d.x); t.y = __builtin_amdgcn_rcpf(d.y);
    f32x2 q = t * 0.5307027145f + (-0.7265760135f); q = q * t + 0.7107068705f; q = q * t + (-0.142248368f); q = q * t + 0.127414796f; q = q * t;
    const f32x2 s = (v * v) * (-0.72134752044f);
    f32x2 e; e.x = __builtin_amdgcn_exp2f(s.x); e.y = __builtin_amdgcn_exp2f(s.y);
    const f32x2 m = v * (q * e), r = v - m;
    f32x2 o; o.x = v.x < 0.f ? m.x : r.x; o.y = v.y < 0.f ? m.y : r.y; return o;
}

__device__ __forceinline__ float silu_f(float v) { return v * __builtin_amdgcn_rcpf(1.0f + __builtin_amdgcn_exp2f(-1.4426950408889634f * v)); }
struct EpiIn {
    static constexpr bool PERM = true, AFTER_DRAIN = false;
    bf16_t* O; int ldc; const float* rowss; float* lnst; float inv_k; float eps;
    template <int MODE> __device__ __forceinline__ void body(const f32x4 (&acc)[2][2][4][2], const Unit& u, int wr, int wc, int fr, int fq) const {
        const int row0 = u.pm * BM + wr * 64 + fr; const int col0 = u.pn * BM + wc * 32 + 8 * fq;
#pragma unroll
        for (int ai = 0; ai < 2; ++ai)
#pragma unroll
            for (int m = 0; m < 4; ++m) {
                const int row = row0 + ai * HALF + m * 16;
                const float rs = __builtin_amdgcn_rsqf(rowss[row] * inv_k + eps);
                bf16_t* rowp = O + (size_t)row * ldc + col0; float s1 = 0.f, s2 = 0.f;
#pragma unroll
                for (int bj = 0; bj < 2; ++bj) { f32x4 v0 = acc[ai][bj][m][0] * rs, v1 = acc[ai][bj][m][1] * rs;
                    if (MODE == 0 || MODE == 1) { f32x2 a = gelu_pk((f32x2){v0[0], v0[1]}), b = gelu_pk((f32x2){v0[2], v0[3]}), c = gelu_pk((f32x2){v1[0], v1[1]}), d = gelu_pk((f32x2){v1[2], v1[3]});
                        v0 = (f32x4){a.x, a.y, b.x, b.y}; v1 = (f32x4){c.x, c.y, d.x, d.y}; }
                    if (MODE == 1) { s1 += ((v0[0] + v0[1]) + (v0[2] + v0[3])) + ((v1[0] + v1[1]) + (v1[2] + v1[3]));
                        s2 += ((v0[0] * v0[0] + v0[1] * v0[1]) + (v0[2] * v0[2] + v0[3] * v0[3])) + ((v1[0] * v1[0] + v1[1] * v1[1]) + (v1[2] * v1[2] + v1[3] * v1[3])); }
                    if (MODE == 2) { v0 = (f32x4){silu_f(v0[0]), silu_f(v0[1]), silu_f(v0[2]), silu_f(v0[3])}; v1 = (f32x4){silu_f(v1[0]), silu_f(v1[1]), silu_f(v1[2]), silu_f(v1[3])}; }
                    if (MODE == 3) { v0 = v0 * 0.12751743074602336f; v1 = v1 * 0.12751743074602336f; }
                    u32x4 w; w.x = cvt_pk_bf16(v0[0], v0[1]); w.y = cvt_pk_bf16(v0[2], v0[3]); w.z = cvt_pk_bf16(v1[0], v1[1]); w.w = cvt_pk_bf16(v1[2], v1[3]);
                    *(u32x4*)(rowp + bj * HALF) = w; }
                if (MODE == 1) { s1 += __shfl_xor(s1, 16); s1 += __shfl_xor(s1, 32); s2 += __shfl_xor(s2, 16); s2 += __shfl_xor(s2, 32);
                    if (fq == 0) { unsafeAtomicAdd(lnst + 2 * (size_t)row, s1); unsafeAtomicAdd(lnst + 2 * (size_t)row + 1, s2); } }
            }
    }
    __device__ __forceinline__ void operator()(const f32x4 (&acc)[2][2][4][2], const Unit& u, int wr, int wc, int fr, int fq) const {
        const int pn = u.pn;
        if (pn < 4) body<0>(acc, u, wr, wc, fr, fq);
        else if (pn < 8) body<1>(acc, u, wr, wc, fr, fq);
        else if (pn < 12 || pn == 18 || pn == 19 || pn >= 22) body<2>(acc, u, wr, wc, fr, fq);
        else if (pn < 14) body<3>(acc, u, wr, wc, fr, fq);
        else body<4>(acc, u, wr, wc, fr, fq);
    }
};
struct EpiKV {
    static constexpr bool PERM = true, AFTER_DRAIN = false;
    bf16_t* O; int ldc; const float* rs_;
    __device__ __forceinline__ void operator()(const f32x4 (&acc)[2][2][4][2], const Unit& u, int wr, int wc, int fr, int fq) const {
        const int row0 = u.pm * BM + wr * 64 + fr; const int col0 = u.pn * BM + wc * 32 + 8 * fq;
#pragma unroll
        for (int ai = 0; ai < 2; ++ai)
#pragma unroll
            for (int m = 0; m < 4; ++m) {
                const int row = row0 + ai * HALF + m * 16; const float rs = rs_[row];
                bf16_t* rowp = O + (size_t)row * ldc + col0;
#pragma unroll
                for (int bj = 0; bj < 2; ++bj) { f32x4 v0 = acc[ai][bj][m][0] * rs, v1 = acc[ai][bj][m][1] * rs;
                    u32x4 w; w.x = cvt_pk_bf16(v0[0], v0[1]); w.y = cvt_pk_bf16(v0[2], v0[3]); w.z = cvt_pk_bf16(v1[0], v1[1]); w.w = cvt_pk_bf16(v1[2], v1[3]);
                    *(u32x4*)(rowp + bj * HALF) = w; }
            }
    }
};
struct EpiOut {
    static constexpr bool PERM = true, AFTER_DRAIN = false;
    const float* basef; const bf16_t* baseb; float* out; int ldc; bf16_t* xb; float* rowss_next;
    __device__ __forceinline__ void operator()(const f32x4 (&acc)[2][2][4][2], const Unit& u, int wr, int wc, int fr, int fq) const {
        const int row0 = u.pm * BM + wr * 64 + fr; const int col0 = u.pn * BM + wc * 32 + 8 * fq;
#pragma unroll
        for (int ai = 0; ai < 2; ++ai)
#pragma unroll
            for (int m = 0; m < 4; ++m) {
                const int row = row0 + ai * HALF + m * 16; const size_t off = (size_t)row * ldc + col0; float ss = 0.f;
#pragma unroll
                for (int bj = 0; bj < 2; ++bj) {
                    f32x4 b0, b1;
                    if (basef) { b0 = *(const f32x4*)(basef + off + bj * HALF); b1 = *(const f32x4*)(basef + off + bj * HALF + 4); }
                    else { const u32x4 w = *(const u32x4*)(baseb + off + bj * HALF);
                        b0 = (f32x4){__uint_as_float(w.x << 16), __uint_as_float(w.x & 0xffff0000u), __uint_as_float(w.y << 16), __uint_as_float(w.y & 0xffff0000u)};
                        b1 = (f32x4){__uint_as_float(w.z << 16), __uint_as_float(w.z & 0xffff0000u), __uint_as_float(w.w << 16), __uint_as_float(w.w & 0xffff0000u)}; }
                    const f32x4 o0 = b0 + acc[ai][bj][m][0], o1 = b1 + acc[ai][bj][m][1];
                    if (out) { *(f32x4*)(out + off + bj * HALF) = o0; *(f32x4*)(out + off + bj * HALF + 4) = o1; }
                    if (xb) { u32x4 w; w.x = cvt_pk_bf16(o0[0], o0[1]); w.y = cvt_pk_bf16(o0[2], o0[3]); w.z = cvt_pk_bf16(o1[0], o1[1]); w.w = cvt_pk_bf16(o1[2], o1[3]);
                        *(u32x4*)(xb + off + bj * HALF) = w;
                        ss += ((o0[0] * o0[0] + o0[1] * o0[1]) + (o0[2] * o0[2] + o0[3] * o0[3])) + ((o1[0] * o1[0] + o1[1] * o1[1]) + (o1[2] * o1[2] + o1[3] * o1[3])); }
                }
                if (xb) { ss += __shfl_xor(ss, 16); ss += __shfl_xor(ss, 32); if (fq == 0) unsafeAtomicAdd(rowss_next + row, ss); }
            }
    }
};

template <class Epi, class Sched, bool ALIGN_EPI = false, bool SP2 = false>
__device__ __forceinline__ void gemm_phase(PG8_LAS unsigned char* lds, const Gemm g, const Sched& S, const Epi& E, int wave_in) {
    int tid_ = wave_in * 64 + (int)__builtin_amdgcn_mbcnt_hi(~0u, __builtin_amdgcn_mbcnt_lo(~0u, 0u)); asm volatile("" : "+v"(tid_));
    const int tid = tid_, wid = __builtin_amdgcn_readfirstlane(tid >> 6), lane = tid & 63, wr = wid >> 2, wc = wid & 3, fr = lane & 15, fq = lane >> 4;
    const int K = g.K, nt = K / BK;
    unsigned voffA[2], voffB[2];
#pragma unroll
    for (int i = 0; i < 2; ++i) { int R, C; stage_rc(tid * 16 + i * 8192, R, C); const int Rb = Epi::PERM ? ((R & ~31) + perm32(R & 31)) : R;
        voffA[i] = (unsigned)(R * K + C) * 2u; voffB[i] = (unsigned)(Rb * K + C) * 2u; }
    const size_t kstep = (size_t)(BK * 2);
    const size_t hstep = (size_t)HALF * K * 2;
    const size_t tstep = 2 * hstep;
    const unsigned ldsw = (unsigned)wid * 1024u;
    const int aoff = lds_byte(wr * 64 + fr, fq * 8), boff = lds_byte(wc * 32 + fr, fq * 8);
#define PG8_SA(b, h) (((b) * 2 + (h)) * HTB)
#define PG8_SB(b, h) ((4 + (b) * 2 + (h)) * HTB)
#define PG8_STAGE(bufoff, gbase, voff) do { _Pragma("unroll") for (int _i = 0; _i < 2; ++_i) \
        __builtin_amdgcn_global_load_lds((const unsigned*)((const char*)(gbase) + (voff)[_i]), (PG8_LAS unsigned*)(lds + (bufoff) + ldsw + _i * 8192), 16, 0, 0); } while (0)
#define PG8_LDA(dst, b, h) do { _Pragma("unroll") for (int m = 0; m < 4; ++m) _Pragma("unroll") for (int k = 0; k < 2; ++k) dst[m][k] = *(const PG8_LAS bf16x8*)(lds + PG8_SA(b, h) + aoff + m * 2048 + k * 1024); } while (0)
#define PG8_LDB(dst, b, h) do { _Pragma("unroll") for (int n = 0; n < 2; ++n) _Pragma("unroll") for (int k = 0; k < 2; ++k) dst[n][k] = *(const PG8_LAS bf16x8*)(lds + PG8_SB(b, h) + boff + n * 2048 + k * 1024); } while (0)
#define PG8_MMA(ai, bj, At, Bt) do { __builtin_amdgcn_s_setprio(1); _Pragma("unroll") for (int m = 0; m < 4; ++m) _Pragma("unroll") for (int n = 0; n < 2; ++n) _Pragma("unroll") for (int k = 0; k < 2; ++k) \
        acc[ai][bj][m][n] = __builtin_amdgcn_mfma_f32_16x16x32_bf16(Bt[n][k], At[m][k], acc[ai][bj][m][n], 0, 0, 0); __builtin_amdgcn_s_setprio(0); } while (0)
#define PG8_WAIT_V(n) asm volatile("s_waitcnt vmcnt(" #n ")" ::: "memory")
#define PG8_WAIT_L(n) asm volatile("s_waitcnt lgkmcnt(" #n ")" ::: "memory")
#define PG8_BAR __builtin_amdgcn_s_barrier()
#define PG8_SCHED __builtin_amdgcn_sched_barrier(0)
    Unit cur, nxt; int ui = 0;
    if (!S.next(0, cur)) return;
    f32x4 acc[2][2][4][2];
#pragma unroll
    for (int a = 0; a < 2; ++a)
#pragma unroll
        for (int b = 0; b < 2; ++b)
#pragma unroll
            for (int m = 0; m < 4; ++m)
#pragma unroll
                for (int n = 0; n < 2; ++n) acc[a][b][m][n] = (f32x4){0.f, 0.f, 0.f, 0.f};
    bf16x8 At[4][2], B0[2][2], B1[2][2];
    const char* cA = (const char*)g.A + (size_t)cur.pm * tstep; const char* cB = (const char*)g.Bt + (size_t)cur.pn * tstep;
    S.a_ready(cur);
    if constexpr (SP2) {
        PG8_STAGE(PG8_SB(0, 0), cB, voffB); PG8_STAGE(PG8_SB(0, 1), cB + hstep, voffB); PG8_STAGE(PG8_SA(0, 0), cA, voffA); PG8_STAGE(PG8_SA(0, 1), cA + hstep, voffA);
        if (wr == 1) PG8_BAR;
        PG8_WAIT_V(2); PG8_BAR;
        PG8_STAGE(PG8_SB(1, 0), cB + kstep, voffB); PG8_STAGE(PG8_SA(1, 0), cA + kstep, voffA); PG8_STAGE(PG8_SB(1, 1), cB + hstep + kstep, voffB);
        PG8_WAIT_V(6); PG8_BAR;
    } else {
        PG8_STAGE(PG8_SB(0, 0), cB, voffB); PG8_STAGE(PG8_SA(0, 0), cA, voffA); PG8_STAGE(PG8_SB(0, 1), cB + hstep, voffB); PG8_STAGE(PG8_SA(0, 1), cA + hstep, voffA);
        if (wr == 1) PG8_BAR;
        PG8_WAIT_V(4); PG8_BAR;
        PG8_STAGE(PG8_SB(1, 0), cB + kstep, voffB); PG8_STAGE(PG8_SA(1, 0), cA + kstep, voffA); PG8_STAGE(PG8_SB(1, 1), cB + hstep + kstep, voffB);
        PG8_WAIT_V(6); PG8_BAR;
    }
    for (;;) {
        const bool has_next = S.next(ui + 1, nxt);
        const char* nA = has_next ? (const char*)g.A + (size_t)nxt.pm * tstep : cA; const char* nB = has_next ? (const char*)g.Bt + (size_t)nxt.pn * tstep : cB;
        for (int t = 0; t < nt; t += 2) {
            const bool last = (t == nt - 2);
            const char* a1 = cA + (size_t)(t + 1) * kstep;
            const char* a2 = last ? nA : cA + (size_t)(t + 2) * kstep; const char* b2 = last ? nB : cB + (size_t)(t + 2) * kstep;
            const char* a3 = a2 + kstep; const char* b3 = b2 + kstep;
            if (last && has_next) S.a_ready(nxt);
            if constexpr (SP2) {
            PG8_LDB(B0, 0, 0); PG8_LDB(B1, 0, 1); PG8_SCHED; PG8_LDA(At, 0, 0); PG8_STAGE(PG8_SA(1, 1), a1 + hstep, voffA);
            PG8_WAIT_V(8); PG8_WAIT_L(0); PG8_BAR; PG8_MMA(0, 0, At, B0); PG8_MMA(0, 1, At, B1); PG8_BAR; PG8_SCHED;
            PG8_LDA(At, 0, 1); PG8_STAGE(PG8_SB(0, 0), b2, voffB); PG8_STAGE(PG8_SB(0, 1), b2 + hstep, voffB); PG8_STAGE(PG8_SA(0, 0), a2, voffA);
            PG8_WAIT_V(8); PG8_WAIT_L(0); PG8_BAR; PG8_MMA(1, 0, At, B0); PG8_MMA(1, 1, At, B1); PG8_BAR; PG8_SCHED;
            PG8_LDB(B0, 1, 0); PG8_LDB(B1, 1, 1); PG8_SCHED; PG8_LDA(At, 1, 0); PG8_STAGE(PG8_SA(0, 1), a2 + hstep, voffA);
            PG8_WAIT_V(8); PG8_WAIT_L(0); PG8_BAR; PG8_MMA(0, 0, At, B0); PG8_MMA(0, 1, At, B1); PG8_BAR; PG8_SCHED;
            PG8_LDA(At, 1, 1); PG8_STAGE(PG8_SB(1, 0), b3, voffB); PG8_STAGE(PG8_SB(1, 1), b3 + hstep, voffB); PG8_STAGE(PG8_SA(1, 0), a3, voffA);
            PG8_WAIT_V(8); PG8_WAIT_L(0); PG8_BAR; PG8_MMA(1, 0, At, B0); PG8_MMA(1, 1, At, B1); PG8_BAR; PG8_SCHED;
            } else {
            PG8_LDB(B0, 0, 0); PG8_SCHED; PG8_LDA(At, 0, 0); PG8_STAGE(PG8_SA(1, 1), a1 + hstep, voffA);
            PG8_WAIT_L(8); PG8_BAR; PG8_WAIT_L(0); PG8_MMA(0, 0, At, B0); PG8_BAR; PG8_SCHED;
            PG8_LDB(B1, 0, 1); PG8_STAGE(PG8_SB(0, 0), b2, voffB);
            PG8_BAR; PG8_WAIT_L(0); PG8_MMA(0, 1, At, B1); PG8_BAR;
            PG8_LDA(At, 0, 1); PG8_STAGE(PG8_SA(0, 0), a2, voffA);
            PG8_BAR; PG8_WAIT_L(0); PG8_MMA(1, 0, At, B0); PG8_BAR; PG8_SCHED;
            PG8_STAGE(PG8_SB(0, 1), b2 + hstep, voffB);
            PG8_WAIT_V(6); PG8_BAR; PG8_MMA(1, 1, At, B1); PG8_BAR;
            PG8_LDB(B0, 1, 0); PG8_SCHED; PG8_LDA(At, 1, 0); PG8_STAGE(PG8_SA(0, 1), a2 + hstep, voffA);
            PG8_WAIT_L(8); PG8_BAR; PG8_WAIT_L(0); PG8_MMA(0, 0, At, B0); PG8_BAR; PG8_SCHED;
            PG8_LDB(B1, 1, 1); PG8_STAGE(PG8_SB(1, 0), b3, voffB);
            PG8_BAR; PG8_WAIT_L(0); PG8_MMA(0, 1, At, B1); PG8_BAR;
            PG8_LDA(At, 1, 1); PG8_STAGE(PG8_SA(1, 0), a3, voffA);
            PG8_BAR; PG8_WAIT_L(0); PG8_MMA(1, 0, At, B0); PG8_BAR; PG8_SCHED;
            PG8_STAGE(PG8_SB(1, 1), b3 + hstep, voffB);
            PG8_WAIT_V(6); PG8_BAR; PG8_MMA(1, 1, At, B1); PG8_BAR;
            }
        }
        if constexpr (ALIGN_EPI) { if (wr == 0) PG8_BAR; }
        if constexpr (!Epi::AFTER_DRAIN) { E(acc, cur, wr, wc, fr, fq); S.done(cur); }
        if (!has_next) break;
#pragma unroll
        for (int a = 0; a < 2; ++a)
#pragma unroll
            for (int b = 0; b < 2; ++b)
#pragma unroll
                for (int m = 0; m < 4; ++m)
#pragma unroll
                    for (int n = 0; n < 2; ++n) acc[a][b][m][n] = (f32x4){0.f, 0.f, 0.f, 0.f};
        cur = nxt; cA = nA; cB = nB; ++ui;
        if constexpr (ALIGN_EPI) { if (wr == 1) PG8_BAR; }
    }
    PG8_WAIT_V(0);
    if constexpr (!ALIGN_EPI) { if (wr == 0) PG8_BAR; }
    PG8_BAR;
    if constexpr (Epi::AFTER_DRAIN) { E.fused(acc, cur, wr, wc, fr, fq, lds, wid, lane); S.done(cur); }
#undef PG8_SA
#undef PG8_SB
#undef PG8_STAGE
#undef PG8_LDA
#undef PG8_LDB
#undef PG8_MMA
#undef PG8_WAIT_V
#undef PG8_WAIT_L
#undef PG8_BAR
#undef PG8_SCHED
}
}
constexpr int NWAVES = 8;
constexpr int DM = 2048, BATCH = 8, SEQ = 2048, M = BATCH * SEQ, DEPTH = 2, MEM_LEN = 256, MM = BATCH * MEM_LEN;
constexpr int NIN = 6144, HD = 128, CHUNK = 128;
constexpr int C_UA = 0, C_VA = 1024, C_ZA = 2048, C_QB = 3072, C_KB = 3584, C_VB = 4096, C_ZB = 4608, C_QC = 5120, C_ZC = 5632;
constexpr float EPS = 1e-6f;
constexpr size_t MiB = 1u << 20;
constexpr size_t WS_WIN = 2 * MiB;
constexpr size_t WS_WOUT = 50 * MiB;
constexpr size_t WS_WKV = 66 * MiB;
constexpr size_t WS_SGUW = 74 * MiB;
constexpr size_t WS_ROWSS0 = 75 * MiB;
constexpr size_t WS_ROWSS1 = WS_ROWSS0 + 65536;
constexpr size_t WS_MEMRS = WS_ROWSS1 + 65536;
constexpr size_t WS_LNST = WS_MEMRS + 8192;
constexpr size_t WS_MEMB = 76 * MiB;
constexpr size_t WS_MEMKV = 84 * MiB;
constexpr size_t WS_XB = 92 * MiB;
constexpr size_t WS_Y = 156 * MiB;
constexpr size_t WS_PROJ = 220 * MiB;
constexpr size_t WS_END = 412 * MiB;
constexpr int LDS_BYTES = 163840;
constexpr int MISC_OFF = LDS_BYTES - 512;
constexpr int VP = 320;

#define LAS __attribute__((address_space(3)))
typedef unsigned short bf16;
typedef unsigned v4u __attribute__((ext_vector_type(4)));
typedef unsigned v2u __attribute__((ext_vector_type(2)));
typedef float f32x4 __attribute__((ext_vector_type(4)));
typedef float f32x16 __attribute__((ext_vector_type(16)));
typedef short bf16x8 __attribute__((ext_vector_type(8)));
typedef short s16x4 __attribute__((ext_vector_type(4)));
#define MFMA32(a, b, c) __builtin_amdgcn_mfma_f32_32x32x16_bf16((a), (b), (c), 0, 0, 0)
#define LDS_WAIT() asm volatile("s_waitcnt lgkmcnt(0)" ::: "memory")

__device__ __forceinline__ unsigned pk2(float lo, float hi) { return pg8::cvt_pk_bf16(lo, hi); }
__device__ __forceinline__ float bflo(unsigned u) { return __uint_as_float(u << 16); }
__device__ __forceinline__ float bfhi(unsigned u) { return __uint_as_float(u & 0xffff0000u); }
__device__ __forceinline__ float swap_add(float v) { auto rr = __builtin_amdgcn_permlane32_swap(__float_as_uint(v), __float_as_uint(v), false, false); return __uint_as_float(rr[0]) + __uint_as_float(rr[1]); }
__device__ __forceinline__ float swap_max(float v) { auto rr = __builtin_amdgcn_permlane32_swap(__float_as_uint(v), __float_as_uint(v), false, false); return fmaxf(__uint_as_float(rr[0]), __uint_as_float(rr[1])); }
__device__ __forceinline__ float wave_sum(float v) {
#pragma unroll
    for (int o = 1; o < 64; o <<= 1) v += __shfl_xor(v, o);
    return v;
}
__device__ __forceinline__ s16x4 trread(LAS const unsigned char* p) { return __builtin_bit_cast(s16x4, __builtin_amdgcn_ds_read_tr16_b64_v4i16((LAS s16x4*)p)); }
__device__ __forceinline__ bf16x8 vfrag(LAS const unsigned char* vl, int off) {
    const s16x4 lo = trread(vl + off), hi = trread(vl + off + 8 * VP);
    return (bf16x8){lo[0], lo[1], lo[2], lo[3], hi[0], hi[1], hi[2], hi[3]};
}
__device__ __forceinline__ int vlane_off(int lane) { return ((lane >> 4) & 1) * 32 + (lane & 3) * 8 + (4 * (lane >> 5) + ((lane & 15) >> 2)) * VP; }
__device__ __forceinline__ bf16x8 packfrag(const f32x16& p, int s) {
    v4u w; w.x = pk2(p[8 * s + 0], p[8 * s + 1]); w.y = pk2(p[8 * s + 2], p[8 * s + 3]); w.z = pk2(p[8 * s + 4], p[8 * s + 5]); w.w = pk2(p[8 * s + 6], p[8 * s + 7]);
    return __builtin_bit_cast(bf16x8, w);
}

typedef __attribute__((address_space(1))) unsigned gu32;
#define XB_TMO      128
#define XB_XCNT(j)  (256  + 64 * (j))
#define XB_XSUB(j)  (1280 + 64 * (j))
#define XB_XGEN(j)  (2304 + 64 * (j))
#define XB_TOP      3328
#define XB_TOPGEN   3392
#define XCD_BAR_WORDS 3456
#define XB_SPIN_CAP (1u << 18)

__device__ __forceinline__ unsigned xb_ld(unsigned* p)              { return __hip_atomic_load(p, __ATOMIC_RELAXED, __HIP_MEMORY_SCOPE_AGENT); }
__device__ __forceinline__ unsigned xb_add(unsigned* p, unsigned v) { return __hip_atomic_fetch_add(p, v, __ATOMIC_RELAXED, __HIP_MEMORY_SCOPE_AGENT); }
__device__ __forceinline__ unsigned xb_xcc_id() { return (unsigned)__builtin_amdgcn_s_getreg((3 << 11) | 20) & 0xFu; }
#define XB_SPIN(cond, bar) do { unsigned _sp = 0; while (cond) { __builtin_amdgcn_s_sleep(1); \
    if ((++_sp & 255u) == 0u) { if (xb_ld(&(bar)[XB_TMO])) break; if (_sp > XB_SPIN_CAP) { atomicAdd(&(bar)[XB_TMO], 1u); break; } } } } while (0)

struct XcdBarrier {
    unsigned* bar; unsigned x;
    volatile LAS unsigned* st;
};

__device__ __forceinline__ XcdBarrier xcd_barrier_post(unsigned* bar, volatile LAS unsigned* st) {
    XcdBarrier b; b.bar = bar; b.x = xb_xcc_id(); b.st = st;
    if (threadIdx.x == 0) (void)xb_add(&bar[XB_XCNT(b.x)], 1u);
    return b;
}
__device__ __forceinline__ void xcd_barrier_complete(unsigned* bar, unsigned x, unsigned& nloc, unsigned& nx, unsigned G) {
    unsigned sum, cnt, mine, sp = 0u;
    for (;;) {
        sum = 0u; cnt = 0u; mine = 0u;
#pragma unroll
        for (unsigned j = 0; j < 16; ++j) { const unsigned c = xb_ld(&bar[XB_XCNT(j)]); sum += c; cnt += (c > 0u) ? 1u : 0u; mine = (j == x) ? c : mine; }
        if (sum == G) break;
        __builtin_amdgcn_s_sleep(1);
        if ((++sp & 255u) == 0u) { if (xb_ld(&bar[XB_TMO])) break; if (sp > XB_SPIN_CAP) { atomicAdd(&bar[XB_TMO], 1u); break; } }
    }
    nloc = mine > 0u ? mine : 1u; nx = cnt > 0u ? cnt : 1u;
}

__device__ __forceinline__ void xcd_barrier(const XcdBarrier& b, bool t0, unsigned Gtot) {
    asm volatile("s_waitcnt vmcnt(0)" ::: "memory");
    __syncthreads();
    if (t0) {
        unsigned* bar = b.bar;
        __builtin_amdgcn_s_waitcnt(0);
        unsigned nloc = b.st[0], nx = b.st[1];
        if (nloc == 0u) { xcd_barrier_complete(bar, b.x, nloc, nx, Gtot); b.st[0] = nloc; b.st[1] = nx; }
        const unsigned old = xb_add(&bar[XB_XSUB(b.x)], 1u);
        const unsigned gen = old / nloc;
        if (old + 1u == (gen + 1u) * nloc) {
            __builtin_amdgcn_fence(__ATOMIC_RELEASE, "agent");
            asm volatile("s_waitcnt vmcnt(0)" ::: "memory");
            const unsigned og = xb_add(&bar[XB_TOP], 1u);
            const unsigned tg = og / nx;
            if (og + 1u == (tg + 1u) * nx) xb_add(&bar[XB_TOPGEN], 1u);
            else XB_SPIN(xb_ld(&bar[XB_TOPGEN]) == tg, bar);
            __builtin_amdgcn_fence(__ATOMIC_ACQUIRE, "agent");
            xb_add(&bar[XB_XGEN(b.x)], 1u);
            asm volatile("s_waitcnt vmcnt(0)" ::: "memory");
        } else {
            XB_SPIN(xb_ld(&bar[XB_XGEN(b.x)]) == gen, bar);
            __builtin_amdgcn_fence(__ATOMIC_ACQUIRE, "agent");
            asm volatile("s_waitcnt vmcnt(0)" ::: "memory");
        }
    }
    __syncthreads();
}

struct Args { const float* in[13]; float* out; unsigned char* ws; };
__device__ __forceinline__ Args load_args() {
    typedef __attribute__((address_space(4))) const unsigned long long* kptr_t;
    kptr_t kp = (kptr_t)__builtin_amdgcn_kernarg_segment_ptr();
    asm volatile("" : "+s"(kp));
    Args a;
#pragma unroll
    for (int k = 0; k < 13; ++k) a.in[k] = (const float*)kp[k];
    a.out = (float*)kp[13]; a.ws = (unsigned char*)kp[14];
    return a;
}
__device__ __forceinline__ int lane_id() { return (int)__builtin_amdgcn_mbcnt_hi(~0u, __builtin_amdgcn_mbcnt_lo(~0u, 0u)); }

__device__ __forceinline__ void p0_transpose_item(const float* W, const float* g, int K, int N, bf16* WT, int row_off, int item, int lane) {
    const int nblk = N / 64, kb = item / nblk, nb = item % nblk, k0 = 64 * kb, n0 = 64 * nb;
    const float* src = W + (size_t)k0 * N + n0 + lane; float v[64];
#pragma unroll
    for (int j = 0; j < 64; ++j) v[j] = __builtin_nontemporal_load(src + (size_t)j * N);
    if (g) {
#pragma unroll
        for (int j = 0; j < 64; ++j) v[j] *= g[k0 + j]; }
    bf16* dst = WT + (size_t)(row_off + n0 + lane) * K + k0;
#pragma unroll
    for (int c = 0; c < 8; ++c) { v4u o; o.x = pk2(v[8 * c], v[8 * c + 1]); o.y = pk2(v[8 * c + 2], v[8 * c + 3]); o.z = pk2(v[8 * c + 4], v[8 * c + 5]); o.w = pk2(v[8 * c + 6], v[8 * c + 7]); *(v4u*)(dst + 8 * c) = o; }
}
__device__ __forceinline__ void row2_to_bf16(const float* xa, bf16* oa, const float* xb_, bf16* ob, int lane, float& s0, float& s1) {
    const f32x4* pa = (const f32x4*)xa + lane; const f32x4* pb = (const f32x4*)xb_ + lane; f32x4 va[8], vb[8];
#pragma unroll
    for (int j = 0; j < 8; ++j) { va[j] = __builtin_nontemporal_load(pa + 64 * j); vb[j] = __builtin_nontemporal_load(pb + 64 * j); }
    float a = 0.f, b = 0.f;
#pragma unroll
    for (int j = 0; j < 8; ++j) { a += (va[j].x * va[j].x + va[j].y * va[j].y) + (va[j].z * va[j].z + va[j].w * va[j].w); b += (vb[j].x * vb[j].x + vb[j].y * vb[j].y) + (vb[j].z * vb[j].z + vb[j].w * vb[j].w); }
    v2u* qa = (v2u*)oa + lane; v2u* qb = (v2u*)ob + lane;
#pragma unroll
    for (int j = 0; j < 8; ++j) { v2u w; w.x = pk2(va[j].x, va[j].y); w.y = pk2(va[j].z, va[j].w); qa[64 * j] = w; v2u u; u.x = pk2(vb[j].x, vb[j].y); u.y = pk2(vb[j].z, vb[j].w); qb[64 * j] = u; }
    s0 = wave_sum(a); s1 = wave_sum(b);
}
__device__ __forceinline__ float row_to_bf16(const float* xrow, bf16* orow, int lane) {
    const f32x4* xr = (const f32x4*)xrow + lane; f32x4 v[8]; float s = 0.f;
#pragma unroll
    for (int j = 0; j < 8; ++j) { v[j] = __builtin_nontemporal_load(xr + 64 * j); s += (v[j].x * v[j].x + v[j].y * v[j].y) + (v[j].z * v[j].z + v[j].w * v[j].w); }
    v2u* o8 = (v2u*)orow + lane;
#pragma unroll
    for (int j = 0; j < 8; ++j) { v2u w; w.x = pk2(v[j].x, v[j].y); w.y = pk2(v[j].z, v[j].w); o8[64 * j] = w; }
    return wave_sum(s);
}

__device__ __forceinline__ void p0_common(const Args& a, int tid, int lane, int wave, int G, int grp, int lb, int GB) {
    unsigned char* ws = a.ws;
    { const int gw = blockIdx.x * NWAVES + wave, NGW = G * NWAVES; constexpr int I_IN = (DM / 64) * (NIN / 64);
      for (int it = gw; it < I_IN; it += NGW) p0_transpose_item(a.in[3], a.in[2], DM, NIN, (bf16*)(ws + WS_WIN), 0, it, lane); }
    { const int gw = lb * NWAVES + wave, NGW = GB * NWAVES; const int m0 = grp * (M / 2); float* rowss0 = (float*)(ws + WS_ROWSS0);
      for (int m = m0 + gw; m < m0 + M / 2; m += 2 * NGW) { const int m2 = m + NGW;
          if (m2 < m0 + M / 2) { float s0, s1; row2_to_bf16(a.in[0] + (size_t)m * DM, (bf16*)(ws + WS_XB) + (size_t)m * DM, a.in[0] + (size_t)m2 * DM, (bf16*)(ws + WS_XB) + (size_t)m2 * DM, lane, s0, s1); if (lane == 0) { rowss0[m] = s0; rowss0[m2] = s1; } }
          else { const float ss = row_to_bf16(a.in[0] + (size_t)m * DM, (bf16*)(ws + WS_XB) + (size_t)m * DM, lane); if (lane == 0) rowss0[m] = ss; } } }
    const int gt = blockIdx.x * (NWAVES * 64) + tid, NGT = G * NWAVES * 64;
    for (int i = gt; i < M / 4; i += NGT) ((f32x4*)(ws + WS_ROWSS1))[i] = (f32x4){0.f, 0.f, 0.f, 0.f};
    for (int i = gt; i < DEPTH * M * 2 / 4; i += NGT) ((f32x4*)(ws + WS_LNST))[i] = (f32x4){0.f, 0.f, 0.f, 0.f};
}
__device__ __forceinline__ void p0_memside(const Args& a, int tid, int lane, int wave, int vb, int NB) {
    unsigned char* ws = a.ws;
    const int gw = vb * NWAVES + wave, NGW = NB * NWAVES;
    constexpr int I_KV = (DM / 64) * (1024 / 64);
    for (int it = gw; it < DEPTH * I_KV; it += NGW) { const int l = it / I_KV, r = it - l * I_KV;
        p0_transpose_item(a.in[9] + (size_t)l * DM * 1024, a.in[8] + l * DM, DM, 1024, (bf16*)(ws + WS_WKV), l * 1024, r, lane); }
    float* memrs = (float*)(ws + WS_MEMRS);
    for (int m = gw; m < MM; m += NGW) { const float ss = row_to_bf16(a.in[1] + (size_t)m * DM, (bf16*)(ws + WS_MEMB) + (size_t)m * DM, lane); if (lane == 0) memrs[m] = __builtin_amdgcn_rsqf(ss * (1.0f / DM) + EPS); }
    const int gt = vb * (NWAVES * 64) + tid, NGT = NB * NWAVES * 64;
    for (int i = gt; i < DEPTH * 8 * 128 * 128 / 4; i += NGT) { const f32x4 w = ((const f32x4*)a.in[6])[i]; const int e = i * 4, s = e & 127, t = (e >> 7) & 127;
        v2u o; o.x = pk2(s <= t ? w.x : 0.f, s + 1 <= t ? w.y : 0.f); o.y = pk2(s + 2 <= t ? w.z : 0.f, s + 3 <= t ? w.w : 0.f); ((v2u*)(ws + WS_SGUW))[i] = o; }
}
__device__ __forceinline__ void p0_late_weights(const Args& a, int lane, int wave, int vb, int NB) {
    unsigned char* ws = a.ws;
    const int gw = vb * NWAVES + wave, NGW = NB * NWAVES;
    constexpr int I_IN = (DM / 64) * (NIN / 64), I_OUT = (DM / 64) * (DM / 64), NQ = I_OUT + I_IN + I_OUT;
    for (int it = gw; it < NQ; it += NGW) {
        if (it < I_OUT) p0_transpose_item(a.in[12], nullptr, DM, DM, (bf16*)(ws + WS_WOUT), 0, it, lane);
        else if (it < I_OUT + I_IN) p0_transpose_item(a.in[3] + (size_t)DM * NIN, a.in[2] + DM, DM, NIN, (bf16*)(ws + WS_WIN) + (size_t)NIN * DM, 0, it - I_OUT, lane);
        else p0_transpose_item(a.in[12] + (size_t)DM * DM, nullptr, DM, DM, (bf16*)(ws + WS_WOUT) + (size_t)DM * DM, 0, it - I_OUT - I_IN, lane);
    }
}

struct ARaw { v4u v[4], u[4], z[4]; float s1[4], s2[4]; };
__device__ __forceinline__ void mixer_a_load_v(const Args& a, int l, int item, int tid, ARaw& R) {
    const unsigned char* ws = a.ws; const bf16* proj = (const bf16*)(ws + WS_PROJ); const float* lnst = (const float*)(ws + WS_LNST) + (size_t)l * M * 2;
    const int g = item & 7, c = (item >> 3) & 15, b = item >> 7; const int tok0 = b * SEQ + c * CHUNK;
#pragma unroll
    for (int i = 0; i < 4; ++i) { const int row = (i * 512 + tid) >> 4, ch = tid & 15; const size_t tok = (size_t)(tok0 + row);
        R.v[i] = __builtin_nontemporal_load((const v4u*)(proj + tok * NIN + C_VA + g * 128 + ch * 8)); R.s1[i] = lnst[2 * tok]; R.s2[i] = lnst[2 * tok + 1]; }
}
__device__ __forceinline__ void mixer_a_load_uz(const Args& a, int item, int tid, ARaw& R) {
    const unsigned char* ws = a.ws; const bf16* proj = (const bf16*)(ws + WS_PROJ);
    const int g = item & 7, c = (item >> 3) & 15, b = item >> 7; const int tok0 = b * SEQ + c * CHUNK;
#pragma unroll
    for (int i = 0; i < 4; ++i) { const int row = (i * 512 + tid) >> 4, ch = tid & 15; const size_t tok = (size_t)(tok0 + row);
        R.u[i] = __builtin_nontemporal_load((const v4u*)(proj + tok * NIN + C_UA + g * 128 + ch * 8)); R.z[i] = __builtin_nontemporal_load((const v4u*)(proj + tok * NIN + C_ZA + g * 128 + ch * 8)); }
}
__device__ __forceinline__ void mixer_a_all(const Args& a, int l, LAS unsigned char* lds, int tid, int lane, int wave, int item0, int NITEM, int G) {
    unsigned char* ws = a.ws; bf16* Y = (bf16*)(ws + WS_Y);
    constexpr int OPP = 528;
    LAS unsigned char* ot = lds + 128 * VP;
    int item = item0; if (item >= NITEM) return;
    ARaw R; mixer_a_load_v(a, l, item, tid, R); mixer_a_load_uz(a, item, tid, R);
    const int r32 = lane & 31, h = lane >> 5, tb = wave >> 1, dh = wave & 1;
    LAS const unsigned char* vl = lds + vlane_off(lane);
    const int g = item & 7;
    const float* lng = a.in[4] + l * 1024 + g * 128 + (tid & 15) * 8; const float* lnb = a.in[5] + l * 1024 + g * 128 + (tid & 15) * 8;
    const f32x4 g0 = *(const f32x4*)(lng), g1 = *(const f32x4*)(lng + 4), b0 = *(const f32x4*)(lnb), b1 = *(const f32x4*)(lnb + 4);
    const bf16* W = (const bf16*)(ws + WS_SGUW) + ((size_t)(l * 8 + g) * 128 + 32 * tb + r32) * 128;
    bf16x8 wf[8];
#pragma unroll
    for (int s = 0; s < 8; ++s) { const v2u wlo = *(const v2u*)(W + 16 * s + 4 * h), whi = *(const v2u*)(W + 16 * s + 8 + 4 * h); wf[s] = __builtin_bit_cast(bf16x8, (v4u){wlo.x, wlo.y, whi.x, whi.y}); }
    float bvs[4];
#pragma unroll
    for (int i = 0; i < 4; ++i) bvs[i] = a.in[7][(size_t)(l * 8 + g) * 128 + ((i * 512 + tid) >> 4)];
    for (; item < NITEM; item += G) {
        const int c = (item >> 3) & 15, b = item >> 7; const int tok0 = b * SEQ + c * CHUNK;
        {
#pragma unroll
          for (int i = 0; i < 4; ++i) { const int row = (i * 512 + tid) >> 4, ch = tid & 15; const v4u raw = R.v[i];
            const float mean = R.s1[i] * (1.0f / 1024), var = R.s2[i] * (1.0f / 1024) - mean * mean; const float rstd = __builtin_amdgcn_rsqf(fmaxf(var, 0.f) + EPS);
            v4u o; o.x = pk2((bflo(raw.x) - mean) * rstd * g0.x + b0.x, (bfhi(raw.x) - mean) * rstd * g0.y + b0.y); o.y = pk2((bflo(raw.y) - mean) * rstd * g0.z + b0.z, (bfhi(raw.y) - mean) * rstd * g0.w + b0.w);
            o.z = pk2((bflo(raw.z) - mean) * rstd * g1.x + b1.x, (bfhi(raw.z) - mean) * rstd * g1.y + b1.y); o.w = pk2((bflo(raw.w) - mean) * rstd * g1.z + b1.z, (bfhi(raw.w) - mean) * rstd * g1.w + b1.w);
            *(LAS v4u*)(lds + row * VP + ch * 16) = o; } }
        __syncthreads();
        const int nitem = item + G;
        if (nitem < NITEM) mixer_a_load_v(a, l, nitem, tid, R);
        f32x16 o0 = {}, o1 = {};
#pragma unroll
        for (int s = 0; s < 8; ++s) if (s < 2 * tb + 2) {
            o0 = MFMA32(wf[s], vfrag(vl, 16 * s * VP + (dh * 2 + 0) * 64), o0);
            o1 = MFMA32(wf[s], vfrag(vl, 16 * s * VP + (dh * 2 + 1) * 64), o1); }
#pragma unroll
        for (int r = 0; r < 16; ++r) { LAS unsigned char* p = ot + (32 * tb + (r & 3) + 8 * (r >> 2) + 4 * h) * OPP + (dh * 64 + r32) * 4; *(LAS float*)p = o0[r]; *(LAS float*)(p + 128) = o1[r]; }
        __syncthreads();
#pragma unroll
        for (int i = 0; i < 4; ++i) { const int row = (i * 512 + tid) >> 4, ch = tid & 15; const float bv = bvs[i];
            const f32x4 m0 = *(LAS const f32x4*)(ot + row * OPP + ch * 32), m1 = *(LAS const f32x4*)(ot + row * OPP + ch * 32 + 16);
            const v4u u = R.u[i], z = R.z[i]; v4u w;
            w.x = pk2((m0.x + bv) * bflo(u.x) * bflo(z.x), (m0.y + bv) * bfhi(u.x) * bfhi(z.x)); w.y = pk2((m0.z + bv) * bflo(u.y) * bflo(z.y), (m0.w + bv) * bfhi(u.y) * bfhi(z.y));
            w.z = pk2((m1.x + bv) * bflo(u.z) * bflo(z.z), (m1.y + bv) * bfhi(u.z) * bfhi(z.z)); w.w = pk2((m1.z + bv) * bflo(u.w) * bflo(z.w), (m1.w + bv) * bfhi(u.w) * bfhi(z.w));
            *(v4u*)(Y + (size_t)(tok0 + row) * DM + g * 128 + ch * 8) = w; }
        if (nitem < NITEM) mixer_a_load_uz(a, nitem, tid, R);
    }
    __syncthreads();
}

__device__ __forceinline__ void out_stage(const f32x16 (&o)[4], LAS unsigned char* scr, const bf16* gate, bf16* y, int lane) {
    const int r32 = lane & 31, h = lane >> 5; constexpr int OP = 272;
    v4u zgs[2][4];
#pragma unroll
    for (int half = 0; half < 2; ++half)
#pragma unroll
        for (int i = 0; i < 4; ++i) zgs[half][i] = __builtin_nontemporal_load((const v4u*)(gate + (size_t)((i * 64 + lane) >> 3) * NIN + half * 64 + (lane & 7) * 8));
#pragma unroll
    for (int half = 0; half < 2; ++half) {
#pragma unroll
        for (int d2 = 0; d2 < 2; ++d2)
#pragma unroll
            for (int r = 0; r < 16; ++r) *(LAS float*)(scr + ((r & 3) + 8 * (r >> 2) + 4 * h) * OP + (d2 * 32 + r32) * 4) = o[2 * half + d2][r];
#pragma unroll
        for (int i = 0; i < 4; ++i) { const int row = (i * 64 + lane) >> 3, c8 = lane & 7;
            const f32x4 a = *(LAS const f32x4*)(scr + row * OP + c8 * 32), b = *(LAS const f32x4*)(scr + row * OP + c8 * 32 + 16);
            const v4u zg = zgs[half][i];
            v4u w; w.x = pk2(a.x * bflo(zg.x), a.y * bfhi(zg.x)); w.y = pk2(a.z * bflo(zg.y), a.w * bfhi(zg.y)); w.z = pk2(b.x * bflo(zg.z), b.y * bfhi(zg.z)); w.w = pk2(b.z * bflo(zg.w), b.w * bfhi(zg.w));
            *(v4u*)(y + (size_t)row * DM + half * 64 + c8 * 8) = w; }
    }
}
__device__ __forceinline__ void mixer_b(const Args& a, int item, LAS unsigned char* lds, int lane, int wave) {
    unsigned char* ws = a.ws; const bf16* proj = (const bf16*)(ws + WS_PROJ); bf16* Y = (bf16*)(ws + WS_Y);
    const int qb = item & 7, hh = (item >> 3) & 3, b = item >> 5; const int tb = b * SEQ; const int q0 = qb * 256 + wave * 32;
    const int r32 = lane & 31, h = lane >> 5;
    constexpr int QP = 272;
    LAS unsigned char* wv = lds + wave * (32 * 256 + 32 * QP); LAS unsigned char* wq = wv + 32 * 256;
#pragma unroll
    for (int i = 0; i < 8; ++i) { const int idx = i * 64 + lane; *(LAS v4u*)(wq + (idx >> 4) * QP + (idx & 15) * 16) = *(const v4u*)(proj + (size_t)(tb + q0 + (idx >> 4)) * NIN + C_QB + hh * HD + (idx & 15) * 8); }
    LAS const unsigned char* qrd = wq + r32 * QP + h * 16;
    f32x16 o[4]; o[0] = f32x16{}; o[1] = f32x16{}; o[2] = f32x16{}; o[3] = f32x16{};
    float R = 0.f; const int ktd = q0 >> 5;
    const unsigned koff = (unsigned)((r32 * NIN + C_KB + hh * HD + 8 * h) * 2);
    const unsigned voff = (unsigned)(((lane >> 4) * NIN + C_VB + hh * HD + (((lane & 15) ^ (4 * ((lane >> 4) & 3))) * 8)) * 2);
#define B_DMA_V(kt_) do { const char* _g = (const char*)proj + ((size_t)tb + 32 * (kt_)) * (NIN * 2); _Pragma("unroll") for (int _i = 0; _i < 8; ++_i) \
        __builtin_amdgcn_global_load_lds((const unsigned*)(_g + (size_t)(4 * _i) * (NIN * 2) + voff), (LAS unsigned*)(wv + _i * 1024), 16, 0, 0); } while (0)
    const int sw = (lane & 15) >> 2;
    LAS const unsigned char* vl = wv + (4 * h + sw) * 256 + ((lane >> 4) & 1) * 32 + (lane & 3) * 8;
    bf16x8 kf[8];
#pragma unroll
    for (int s = 0; s < 8; ++s) kf[s] = *(const bf16x8*)((const char*)proj + ((size_t)tb + 32 * ktd) * (NIN * 2) + koff + 32 * s);
    for (int kt = ktd; kt >= 0; --kt) {
        f32x16 z = {};
#pragma unroll
        for (int s = 0; s < 8; ++s) z = MFMA32(kf[s], *(LAS const bf16x8*)(qrd + 32 * s), z);
        asm volatile("" : "+v"(z) :: "memory");
        __builtin_amdgcn_sched_barrier(0);
        { const char* nb = (const char*)proj + ((size_t)tb + 32 * (kt > 0 ? kt - 1 : 0)) * (NIN * 2);
#pragma unroll
          for (int s = 0; s < 8; ++s) kf[s] = *(const bf16x8*)(nb + koff + 32 * s); }
        B_DMA_V(kt);
        const bool diag = (kt == ktd);
        f32x16 lb, l1; float tsum = 0.f;
#pragma unroll
        for (int r = 0; r < 16; ++r) { const float zz = z[r]; const float e = __builtin_amdgcn_exp2f(-fabsf(zz)); const float lp = __builtin_amdgcn_logf(1.0f + e);
            const float lbv = fminf(zz, 0.f) - lp; const int key = (r & 3) + 8 * (r >> 2) + 4 * h; const bool valid = !diag || key < r32;
            lb[r] = valid ? lbv : -1e30f; const float lv = valid ? (lbv - zz) : 0.f; l1[r] = lv; tsum += lv; }
        bf16x8 hf0, hf1, lf0, lf1;
        { v4u H0, H1, L0, L1;
#pragma unroll
          for (int p = 0; p < 4; ++p) { const unsigned u0 = pk2(l1[2 * p], l1[2 * p + 1]), u1 = pk2(l1[8 + 2 * p], l1[8 + 2 * p + 1]);
              H0[p] = u0; H1[p] = u1; L0[p] = pk2(l1[2 * p] - bflo(u0), l1[2 * p + 1] - bfhi(u0)); L1[p] = pk2(l1[8 + 2 * p] - bflo(u1), l1[8 + 2 * p + 1] - bfhi(u1)); }
          hf0 = __builtin_bit_cast(bf16x8, H0); hf1 = __builtin_bit_cast(bf16x8, H1); lf0 = __builtin_bit_cast(bf16x8, L0); lf1 = __builtin_bit_cast(bf16x8, L1); }
        bf16x8 T0, T1;
        { int ro = r32 - 4 * h; asm volatile("" : "+v"(ro));
#pragma unroll
          for (int j = 0; j < 8; ++j) { const int k = 8 * (j >> 2) + (j & 3); T0[j] = (k > ro) ? (short)0x3F80 : (short)0; T1[j] = (16 + k > ro) ? (short)0x3F80 : (short)0; } }
        f32x16 cs = {};
        cs = MFMA32(T0, hf0, cs); cs = MFMA32(T1, hf1, cs); cs = MFMA32(T0, lf0, cs); cs = MFMA32(T1, lf1, cs);
        f32x16 p;
#pragma unroll
        for (int r = 0; r < 16; ++r) p[r] = __builtin_amdgcn_exp2f(lb[r] + cs[r] + R);
        const bf16x8 pa0 = packfrag(p, 0), pa1 = packfrag(p, 1);
        R += swap_add(tsum);
        asm volatile("s_waitcnt vmcnt(0)" ::: "memory");
#pragma unroll
        for (int d = 0; d < 4; ++d) { const int go = ((d ^ sw) * 64);
            const s16x4 a0 = trread(vl + go), a1 = trread(vl + go + 8 * 256), b0 = trread(vl + go + 16 * 256), b1 = trread(vl + go + 24 * 256);
            o[d] = MFMA32(pa0, ((bf16x8){a0[0], a0[1], a0[2], a0[3], a1[0], a1[1], a1[2], a1[3]}), o[d]);
            o[d] = MFMA32(pa1, ((bf16x8){b0[0], b0[1], b0[2], b0[3], b1[0], b1[1], b1[2], b1[3]}), o[d]); }
        const bool stop = (__builtin_amdgcn_ballot_w64(R >= -158.7f) == 0ull) || kt == 0;
        asm volatile("s_waitcnt lgkmcnt(0)" ::: "memory");
        if (stop) break;
    }
#undef B_DMA_V
    out_stage(o, wq, proj + (size_t)(tb + q0) * NIN + C_ZB + hh * HD, Y + (size_t)(tb + q0) * DM + 1024 + hh * HD, lane);
}

__device__ __forceinline__ void mixer_c(const Args& a, int l, int item, LAS unsigned char* lds, int tid, int lane, int wave) {
    unsigned char* ws = a.ws; const bf16* proj = (const bf16*)(ws + WS_PROJ); bf16* Y = (bf16*)(ws + WS_Y); const bf16* kv = (const bf16*)(ws + WS_MEMKV);
    const int qb = item & 7, hh = (item >> 3) & 3, b = item >> 5; const int tb = b * SEQ; const int q0 = qb * 256 + wave * 32;
    const int r32 = lane & 31, h = lane >> 5;
    const bf16* Kb = kv + (size_t)(b * MEM_LEN) * 2048 + l * 1024 + hh * HD; const bf16* Vb = Kb + 512;
    constexpr int KP = 272;
    LAS unsigned char* kt_ = lds + 256 * VP;
    LAS float* rkl = (LAS float*)(lds + 256 * VP + 256 * KP); LAS float* lw = rkl + 256 + wave * 32;
    LAS float* gkl = rkl + 256 + 8 * 32;
    v4u qraw[8];
#pragma unroll
    for (int s = 0; s < 8; ++s) qraw[s] = *(const v4u*)(proj + (size_t)(tb + q0 + r32) * NIN + C_QC + hh * HD + 16 * s + 8 * h);
    if (tid < HD) gkl[tid] = a.in[10][l * HD + tid] * a.in[11][l * HD + tid];
#pragma unroll
    for (int i = 0; i < 8; ++i) { const int idx = i * 512 + tid, row = idx >> 4, ch = idx & 15;
        *(LAS v4u*)(lds + row * VP + ch * 16) = *(const v4u*)(Vb + (size_t)row * 2048 + ch * 8);
        const v4u w = *(const v4u*)(Kb + (size_t)row * 2048 + ch * 8); *(LAS v4u*)(kt_ + row * KP + ch * 16) = w;
        float ss = (bflo(w.x) * bflo(w.x) + bfhi(w.x) * bfhi(w.x)) + (bflo(w.y) * bflo(w.y) + bfhi(w.y) * bfhi(w.y)) + (bflo(w.z) * bflo(w.z) + bfhi(w.z) * bfhi(w.z)) + (bflo(w.w) * bflo(w.w) + bfhi(w.w) * bfhi(w.w));
        ss += __shfl_xor(ss, 1); ss += __shfl_xor(ss, 2); ss += __shfl_xor(ss, 4); ss += __shfl_xor(ss, 8);
        if (ch == 0) rkl[row] = __builtin_amdgcn_rsqf(ss * (1.0f / HD) + EPS); }
    __syncthreads();
    bf16x8 qf[8]; float rq;
    { float ss = 0.f;
#pragma unroll
      for (int s = 0; s < 8; ++s) { const v4u w = qraw[s];
          const f32x4 k0 = *(LAS const f32x4*)(gkl + 16 * s + 8 * h), k1 = *(LAS const f32x4*)(gkl + 16 * s + 8 * h + 4);
          const float x0 = bflo(w.x), x1 = bfhi(w.x), x2 = bflo(w.y), x3 = bfhi(w.y), x4 = bflo(w.z), x5 = bfhi(w.z), x6 = bflo(w.w), x7 = bfhi(w.w);
          ss += (x0 * x0 + x1 * x1) + (x2 * x2 + x3 * x3) + (x4 * x4 + x5 * x5) + (x6 * x6 + x7 * x7);
          v4u o; o.x = pk2(x0 * k0.x, x1 * k0.y); o.y = pk2(x2 * k0.z, x3 * k0.w); o.z = pk2(x4 * k1.x, x5 * k1.y); o.w = pk2(x6 * k1.z, x7 * k1.w);
          qf[s] = __builtin_bit_cast(bf16x8, o); }
      ss = swap_add(ss); rq = __builtin_amdgcn_rsqf(ss * (1.0f / HD) + EPS); }
    LAS const unsigned char* vl = lds + vlane_off(lane);
    LAS const unsigned char* krd = kt_ + r32 * KP + h * 16;
    float mx = -1e30f;
    for (int t8 = 0; t8 < 8; ++t8) {
        f32x16 z = {};
#pragma unroll
        for (int s = 0; s < 8; ++s) z = MFMA32(*(LAS const bf16x8*)(krd + (32 * t8) * KP + 32 * s), qf[s], z);
#pragma unroll
        for (int q = 0; q < 4; ++q) { const f32x4 rk = *(LAS const f32x4*)(rkl + 32 * t8 + 8 * q + 4 * h);
#pragma unroll
            for (int j = 0; j < 4; ++j) mx = fmaxf(mx, z[4 * q + j] * rk[j]); }
    }
    mx = swap_max(mx);
    const float cc = rq * 0.08838834764831845f * 1.4426950408889634f;
    f32x16 o[4]; o[0] = f32x16{}; o[1] = f32x16{}; o[2] = f32x16{}; o[3] = f32x16{};
    float lsum = 0.f;
    for (int t8 = 0; t8 < 8; ++t8) {
        f32x16 z = {};
#pragma unroll
        for (int s = 0; s < 8; ++s) z = MFMA32(*(LAS const bf16x8*)(krd + (32 * t8) * KP + 32 * s), qf[s], z);
        f32x16 p;
#pragma unroll
        for (int q = 0; q < 4; ++q) { const f32x4 rk = *(LAS const f32x4*)(rkl + 32 * t8 + 8 * q + 4 * h);
#pragma unroll
            for (int j = 0; j < 4; ++j) { const float e = __builtin_amdgcn_exp2f((z[4 * q + j] * rk[j] - mx) * cc); p[4 * q + j] = e; lsum += e; } }
        const bf16x8 pa0 = packfrag(p, 0), pa1 = packfrag(p, 1);
#pragma unroll
        for (int d = 0; d < 4; ++d) { o[d] = MFMA32(pa0, vfrag(vl, (32 * t8) * VP + d * 64), o[d]); o[d] = MFMA32(pa1, vfrag(vl, (32 * t8 + 16) * VP + d * 64), o[d]); }
    }
    lsum = swap_add(lsum);
    if (h == 0) lw[r32] = 1.0f / lsum;
    LDS_WAIT(); asm volatile("" ::: "memory");
#pragma unroll
    for (int q = 0; q < 4; ++q) { const f32x4 li = *(LAS const f32x4*)(lw + 8 * q + 4 * h);
#pragma unroll
        for (int j = 0; j < 4; ++j)
#pragma unroll
            for (int d = 0; d < 4; ++d) o[d][4 * q + j] *= li[j]; }
    __syncthreads();
    out_stage(o, kt_ + wave * (32 * 272), proj + (size_t)(tb + q0) * NIN + C_ZC + hh * HD, Y + (size_t)(tb + q0) * DM + 1536 + hh * HD, lane);
    __syncthreads();
}

constexpr int CW_BAR_ALL = 0, CW_BAR_GRP = XCD_BAR_WORDS  , CW_SUB = 3 * XCD_BAR_WORDS + 64, CW_FLAG = 3 * XCD_BAR_WORDS + 128;
static_assert((CW_FLAG + 64) * 4 <= 65536, "control words inside the per-call memset");

__global__ void __launch_bounds__(NWAVES * 64, 2) fwd_mega(Args args_unused) {
    extern __shared__ __attribute__((aligned(16))) unsigned char lds_raw[];
    LAS unsigned char* lds = (LAS unsigned char*)lds_raw;
    cg::grid_group grid = cg::this_grid();
    const int G = gridDim.x, GB = G >> 1;
    const int grp = ((int)blockIdx.x >= GB) ? 1 : 0, lb = (int)blockIdx.x - grp * GB;
    const int wave_s = __builtin_amdgcn_readfirstlane(threadIdx.x >> 6);
#define IDS() int tid = wave_s * 64 + lane_id(); asm volatile("" : "+v"(tid)); const int lane = tid & 63, wave = wave_s; (void)lane; (void)wave
#define XBAR_ALL() do { XcdBarrier b_; b_.bar = (unsigned*)load_args().ws + CW_BAR_ALL; b_.x = xb_xcc_id(); b_.st = (volatile LAS unsigned*)(lds + MISC_OFF) + 8; xcd_barrier(b_, wave_s == 0 && lane_id() == 0, (unsigned)G); } while (0)
#define XBAR() do { XcdBarrier b_; b_.bar = (unsigned*)load_args().ws + CW_BAR_GRP + grp * XCD_BAR_WORDS; b_.x = xb_xcc_id(); b_.st = (volatile LAS unsigned*)(lds + MISC_OFF) + 10; xcd_barrier(b_, wave_s == 0 && lane_id() == 0, (unsigned)GB); } while (0)
    for (int u = threadIdx.x; u < 128; u += NWAVES * 64) ((LAS unsigned*)(lds + MISC_OFF))[u] = 0u;
    __syncthreads();
    (void)xcd_barrier_post((unsigned*)load_args().ws + CW_BAR_ALL, (volatile LAS unsigned*)(lds + MISC_OFF) + 8);
    (void)xcd_barrier_post((unsigned*)load_args().ws + CW_BAR_GRP + grp * XCD_BAR_WORDS, (volatile LAS unsigned*)(lds + MISC_OFF) + 10);
    constexpr int KVB = 64;
    if (load_args().ws == nullptr) grid.sync();
    { IDS(); const Args args = load_args(); p0_common(args, tid, lane, wave, G, grp, lb, GB); }
    XBAR_ALL();
    if (grp == 1) {
        if (lb < KVB) {
            { IDS(); const Args args = load_args(); p0_memside(args, tid, lane, wave, lb, KVB); }
            {   unsigned* cnt = (unsigned*)load_args().ws + CW_SUB;
                asm volatile("s_waitcnt vmcnt(0)" ::: "memory"); __syncthreads();
                if (wave_s == 0 && lane_id() == 0) {
                    __builtin_amdgcn_fence(__ATOMIC_RELEASE, "agent"); asm volatile("s_waitcnt vmcnt(0)" ::: "memory");
                    (void)xb_add(cnt, 1u);
                    unsigned sp = 0; while (xb_ld(cnt) < (unsigned)KVB) { __builtin_amdgcn_s_sleep(1); if (++sp > (1u << 22)) break; }
                    __builtin_amdgcn_fence(__ATOMIC_ACQUIRE, "agent"); asm volatile("s_waitcnt vmcnt(0)" ::: "memory");
                }
                __syncthreads();
                __builtin_amdgcn_fence(__ATOMIC_ACQUIRE, "agent"); asm volatile("s_waitcnt vmcnt(0)" ::: "memory"); }
            unsigned char* ws = load_args().ws;
            pg8::Gemm g2{(const pg8::bf16_t*)(ws + WS_MEMB), (const pg8::bf16_t*)(ws + WS_WKV), MM, 2048, DM};
            pg8::StaticOrder S2; S2.init(MM, 2048, KVB, lb);
            pg8::EpiKV E2{(pg8::bf16_t*)(ws + WS_MEMKV), 2048, (const float*)(ws + WS_MEMRS)};
            pg8::gemm_phase<pg8::EpiKV, pg8::StaticOrder, true, true>(lds, g2, S2, E2, wave_s);
        } else { IDS(); const Args args = load_args(); p0_late_weights(args, lane, wave, lb - KVB, GB - KVB); }
        XBAR();
        if (lb == 0 && wave_s == 0 && lane_id() == 0) {
            __builtin_amdgcn_fence(__ATOMIC_RELEASE, "agent"); asm volatile("s_waitcnt vmcnt(0)" ::: "memory");
            __hip_atomic_store((unsigned*)load_args().ws + CW_FLAG, 1u, __ATOMIC_RELAXED, __HIP_MEMORY_SCOPE_AGENT); }
    }
    const int row0 = grp * (M / 2);
    for (int l = 0; l < DEPTH; ++l) {
        {
            unsigned char* ws = load_args().ws;
            pg8::Gemm g{(const pg8::bf16_t*)(ws + WS_XB) + (size_t)row0 * DM, (const pg8::bf16_t*)(ws + WS_WIN) + (size_t)l * NIN * DM, M / 2, NIN, DM};
            pg8::StaticOrder S; S.init(M / 2, NIN, GB, lb);
            pg8::EpiIn E{(pg8::bf16_t*)(ws + WS_PROJ) + (size_t)row0 * NIN, NIN, (const float*)(ws + (l == 0 ? WS_ROWSS0 : WS_ROWSS1)) + row0, (float*)(ws + WS_LNST) + (size_t)l * M * 2 + (size_t)row0 * 2, 1.0f / DM, EPS};
            pg8::gemm_phase<pg8::EpiIn, pg8::StaticOrder, true, true>(lds, g, S, E, wave_s);
        }
        XBAR();
        if (l == 0 && grp == 0) {
            if (wave_s == 0 && lane_id() == 0) { unsigned* fl = (unsigned*)load_args().ws + CW_FLAG; unsigned sp = 0;
                while (xb_ld(fl) == 0u) { __builtin_amdgcn_s_sleep(1); if (++sp > (1u << 22)) break; }
                __builtin_amdgcn_fence(__ATOMIC_ACQUIRE, "agent"); asm volatile("s_waitcnt vmcnt(0)" ::: "memory"); }
            __syncthreads();
            __builtin_amdgcn_fence(__ATOMIC_ACQUIRE, "agent"); asm volatile("s_waitcnt vmcnt(0)" ::: "memory");
        }
        {
            IDS(); const Args args = load_args();
            const int sub = (int)((unsigned)(2 * (lb & 7) + (lb >> 6)) % 3u);
            const int a0 = grp * (BATCH * 16 * 8 / 2) + lb, a1 = (grp + 1) * (BATCH * 16 * 8 / 2);
            const int b0 = grp * (BATCH * 4 * 8 / 2) + (2 * (lb & 7) + (lb >> 6)) * 8 + ((lb >> 3) & 7), b1 = b0 + 1;
            if (sub == 0) mixer_a_all(args, l, lds, tid, lane, wave, a0, a1, GB);
            for (int it = b0; it < b1; it += GB) mixer_b(args, it, lds, lane, wave);
            __syncthreads();
            if (sub == 1) mixer_a_all(args, l, lds, tid, lane, wave, a0, a1, GB);
            for (int it = b0; it < b1; it += GB) mixer_c(args, l, it, lds, tid, lane, wave);
            if (sub == 2) mixer_a_all(args, l, lds, tid, lane, wave, a0, a1, GB);
        }
        XBAR();
        {
            const Args a_ = load_args(); unsigned char* ws = a_.ws; const size_t ro = (size_t)row0 * DM;
            pg8::Gemm g{(const pg8::bf16_t*)(ws + WS_Y) + ro, (const pg8::bf16_t*)(ws + WS_WOUT) + (size_t)l * DM * DM, M / 2, DM, DM};
            pg8::StaticOrder S; S.init(M / 2, DM, GB, lb);
            pg8::EpiOut E{nullptr, (const pg8::bf16_t*)(ws + WS_XB) + ro, l == 0 ? nullptr : a_.out + ro, DM, l == 0 ? (pg8::bf16_t*)(ws + WS_XB) + ro : nullptr, (float*)(ws + WS_ROWSS1) + row0};
            pg8::gemm_phase<pg8::EpiOut, pg8::StaticOrder, true, true>(lds, g, S, E, wave_s);
        }
        if (l + 1 < DEPTH) XBAR();
    }
}

extern "C" void kernel_launch(void* const* d_in, const int* in_sizes, int n_in, void* d_out, int out_size, void* d_ws, size_t ws_size, hipStream_t stream) {
    static int grid = 0;
    if (grid == 0) {
        if (n_in != 13 || out_size != M * DM || ws_size < WS_END) { fprintf(stderr, "kernel_launch: unexpected shapes (n_in %d out %d ws %zu)\n", n_in, out_size, ws_size); grid = -1; return; }
        int dev = 0, cus = 0, per_cu = 0;
        hipGetDevice(&dev); hipDeviceGetAttribute(&cus, hipDeviceAttributeMultiprocessorCount, dev);
        hipFuncSetAttribute((const void*)fwd_mega, hipFuncAttributeMaxDynamicSharedMemorySize, LDS_BYTES);
        hipOccupancyMaxActiveBlocksPerMultiprocessor(&per_cu, (const void*)fwd_mega, NWAVES * 64, LDS_BYTES);
        if (per_cu < 1) { fprintf(stderr, "kernel_launch: occupancy query says %d blocks per CU\n", per_cu); per_cu = 1; }
        (void)hipGetLastError();
        grid = cus * per_cu;
        if (grid < 256 || grid % 16 != 0) { fprintf(stderr, "kernel_launch: grid %d too small for this kernel\n", grid); grid = -1; return; }
    }
    if (grid < 0) return;
    Args a{};
    for (int i = 0; i < 13; ++i) a.in[i] = (const float*)d_in[i];
    a.out = (float*)d_out; a.ws = (unsigned char*)d_ws;
    if (hipMemsetAsync(d_ws, 0, 65536, stream) != hipSuccess) { fprintf(stderr, "kernel_launch: memset failed\n"); return; }
    void* kargs[] = {&a};
    hipError_t e = hipLaunchCooperativeKernel((void*)fwd_mega, dim3(grid), dim3(NWAVES * 64), kargs, LDS_BYTES, stream);
    if (e != hipSuccess) fprintf(stderr, "kernel_launch: cooperative launch failed: %s (grid %d)\n", hipGetErrorString(e), grid);
}
```
